# Optimizing an MI355X kernel written in HIP

```python
import math
import jax, jax.numpy as jnp
from jax import lax
import numpy as np

D_MODEL = 1024
BATCH = 8
SEQ = 2048
DEPTH = 2
DEC_BATCH = 128
DEC_SEQ = 8
PAST_LEN = 16384
PAGE_SIZE = 128

D_CONV = D_MODEL
CONV_A_W = 3
D_RNN = D_MODEL
CONV_B_W = 4
N_BLK = 16
BLK = D_RNN // N_BLK
LRU_C = 8.0
N_MEM = 256
MEM_HEADS = 4
MEM_HEAD_DIM = D_MODEL // MEM_HEADS
D_FF = int(math.ceil(8 * D_MODEL / 3 / 256) * 256)
N_NORMS = 7
EPS = 1e-6
D_IN = 3 * D_CONV + D_RNN + 2 * D_MODEL

kernel_name = "hybrid_conv_rglru_xattn_decoder_step"


def rms_norm(x, g):
    xf = x.astype(jnp.float32)
    y = xf * lax.rsqrt(jnp.mean(xf * xf, axis=-1, keepdims=True) + EPS)
    return (y * g.astype(jnp.float32)).astype(x.dtype)


def causal_dwconv(x, buf, w):
    width = w.shape[0]
    t = x.shape[1]
    xp = jnp.concatenate([buf.astype(x.dtype), x], axis=1)
    y = xp[:, 0:t] * w[0]
    for k in range(1, width):
        y = y + xp[:, k:k + t] * w[k]
    return y, xp[:, t:]


def rg_lru(u, h0, w_a, b_a, w_x, b_x, lam):
    bsz, t, c = u.shape
    ub = u.reshape(bsz, t, N_BLK, BLK)
    r = jax.nn.sigmoid(jnp.einsum('btnk,nkj->btnj', ub, w_a).reshape(bsz, t, c) + b_a)
    i = jax.nn.sigmoid(jnp.einsum('btnk,nkj->btnj', ub, w_x).reshape(bsz, t, c) + b_x)
    log_a = -LRU_C * r.astype(jnp.float32) * jax.nn.softplus(-lam.astype(jnp.float32))
    a = jnp.exp(log_a)
    mult = jnp.sqrt(-jnp.expm1(2.0 * log_a))
    b = mult * (i * u).astype(jnp.float32)
    b = b.at[:, 0].add(a[:, 0] * h0.astype(jnp.float32))

    def combine(c1, c2):
        a1, b1 = c1
        a2, b2 = c2
        return a1 * a2, a2 * b1 + b2

    _, h = lax.associative_scan(combine, (a, b), axis=1)
    return h.astype(u.dtype), h[:, -1]


def mem_kv(mem, g_mem, w_kv):
    m = rms_norm(mem, g_mem)
    kv = (m @ w_kv).reshape(mem.shape[0], N_MEM, 2, MEM_HEADS, MEM_HEAD_DIM)
    return kv[:, :, 0], kv[:, :, 1]


def cross_attend(xn, mk, mv, w_q, w_o):
    bsz, t, _ = xn.shape
    q = (xn @ w_q).reshape(bsz, t, MEM_HEADS, MEM_HEAD_DIM)
    s = jnp.einsum('bthd,bmhd->bhtm', q.astype(jnp.float32), mk.astype(jnp.float32)) * (MEM_HEAD_DIM ** -0.5)
    p = jax.nn.softmax(s, axis=-1).astype(xn.dtype)
    o = jnp.einsum('bhtm,bmhd->bthd', p, mv.astype(xn.dtype)).reshape(bsz, t, D_MODEL)
    return o @ w_o


def layer(x, mk, mv, buf_a, buf_b, h0, lw):
    (g, w_in, conv_a_w, w_conv_out, conv_b_w, conv_b_b, w_gate_a, b_gate_a, w_gate_x, b_gate_x,
     lru_lambda, w_rnn_out, w_mix_out, w_q_x, w_o_x, w_ffn_in, w_ffn_out) = lw
    xn = rms_norm(x, g[0])
    proj = xn @ w_in
    cuts = [D_CONV, 2 * D_CONV, 3 * D_CONV, 3 * D_CONV + D_RNN, 3 * D_CONV + D_RNN + D_MODEL]
    hb, hc, hh, u, gc, gr = jnp.split(proj, cuts, axis=-1)
    ya, new_a = causal_dwconv(hc * hh, buf_a, conv_a_w)
    y_conv = (hb * ya) @ w_conv_out
    uc, new_b = causal_dwconv(u, buf_b, conv_b_w)
    uc = uc + conv_b_b
    hseq, h_last = rg_lru(uc, h0, w_gate_a, b_gate_a, w_gate_x, b_gate_x, lru_lambda)
    y_rnn = hseq @ w_rnn_out
    z = jax.nn.sigmoid(gc) * y_conv + jax.nn.sigmoid(gr) * y_rnn
    x = x + rms_norm(z @ w_mix_out, g[1])
    x = x + rms_norm(cross_attend(rms_norm(x, g[2]), mk, mv, w_q_x, w_o_x), g[3])
    xn = rms_norm(x, g[4])
    gate, up = jnp.split(xn @ w_ffn_in, 2, axis=-1)
    x = x + rms_norm((jax.nn.silu(gate) * up) @ w_ffn_out, g[5])
    return x, new_a, new_b, h_last


def setup_inputs(seed: int = 0) -> dict:
    key = jax.random.key(seed)
    ks = jax.random.split(key, 32)
    f32 = jnp.float32
    nrm = lambda k, shape, s: (jax.random.normal(k, shape, f32) * s)
    a_init = jax.random.uniform(ks[20], (DEPTH, D_RNN), f32, 0.9, 0.999)
    return {
        "x_prompt": nrm(ks[0], (BATCH, SEQ, D_MODEL), 1.0),
        "x_sample": nrm(ks[1], (DEC_BATCH, DEC_SEQ, D_MODEL), 1.0),
        "state_conv_a": nrm(ks[2], (DEPTH, DEC_BATCH, CONV_A_W - 1, D_CONV), 1.0),
        "state_conv_b": nrm(ks[3], (DEPTH, DEC_BATCH, CONV_B_W - 1, D_RNN), 1.0),
        "state_rglru": nrm(ks[4], (DEPTH, DEC_BATCH, D_RNN), 0.5),
        "cache_mem_k": nrm(ks[5], (DEPTH, DEC_BATCH, N_MEM, MEM_HEADS, MEM_HEAD_DIM), 1.0),
        "cache_mem_v": nrm(ks[6], (DEPTH, DEC_BATCH, N_MEM, MEM_HEADS, MEM_HEAD_DIM), 1.0),
        "mem_prompt": nrm(ks[7], (BATCH, N_MEM, D_MODEL), 1.0),
        "norm_gains": 1.0 + nrm(ks[8], (DEPTH, N_NORMS, D_MODEL), 0.05),
        "w_in": nrm(ks[9], (DEPTH, D_MODEL, D_IN), D_MODEL ** -0.5),
        "conv_a_w": nrm(ks[10], (DEPTH, CONV_A_W, D_CONV), CONV_A_W ** -0.5),
        "w_conv_out": nrm(ks[11], (DEPTH, D_CONV, D_MODEL), D_CONV ** -0.5),
        "conv_b_w": nrm(ks[12], (DEPTH, CONV_B_W, D_RNN), CONV_B_W ** -0.5),
        "conv_b_b": nrm(ks[13], (DEPTH, D_RNN), 0.01),
        "w_gate_a": nrm(ks[14], (DEPTH, N_BLK, BLK, BLK), BLK ** -0.5),
        "b_gate_a": nrm(ks[15], (DEPTH, D_RNN), 0.01),
        "w_gate_x": nrm(ks[16], (DEPTH, N_BLK, BLK, BLK), BLK ** -0.5),
        "b_gate_x": nrm(ks[17], (DEPTH, D_RNN), 0.01),
        "lru_lambda": jnp.log(a_init) - jnp.log1p(-a_init),
        "w_rnn_out": nrm(ks[18], (DEPTH, D_RNN, D_MODEL), D_RNN ** -0.5),
        "w_mix_out": nrm(ks[19], (DEPTH, D_MODEL, D_MODEL), D_MODEL ** -0.5),
        "w_kv_x": nrm(ks[21], (DEPTH, D_MODEL, 2 * D_MODEL), D_MODEL ** -0.5),
        "w_q_x": nrm(ks[22], (DEPTH, D_MODEL, D_MODEL), D_MODEL ** -0.5),
        "w_o_x": nrm(ks[23], (DEPTH, D_MODEL, D_MODEL), D_MODEL ** -0.5),
        "w_ffn_in": nrm(ks[24], (DEPTH, D_MODEL, 2 * D_FF), D_MODEL ** -0.5),
        "w_ffn_out": nrm(ks[25], (DEPTH, D_FF, D_MODEL), D_FF ** -0.5),
    }


def reference(x_prompt, x_sample, state_conv_a, state_conv_b, state_rglru, cache_mem_k, cache_mem_v,
              mem_prompt, norm_gains, w_in, conv_a_w, w_conv_out, conv_b_w, conv_b_b, w_gate_a, b_gate_a,
              w_gate_x, b_gate_x, lru_lambda, w_rnn_out, w_mix_out, w_kv_x, w_q_x, w_o_x, w_ffn_in, w_ffn_out):
    xp, xs = x_prompt, x_sample
    bsz = xp.shape[0]
    zero_a = jnp.zeros((bsz, CONV_A_W - 1, D_CONV), xp.dtype)
    zero_b = jnp.zeros((bsz, CONV_B_W - 1, D_RNN), xp.dtype)
    zero_h = jnp.zeros((bsz, D_RNN), jnp.float32)
    pa, pb, ph, pk, pv, sa, sb, sh = [], [], [], [], [], [], [], []
    for l in range(DEPTH):
        lw = (norm_gains[l], w_in[l], conv_a_w[l], w_conv_out[l], conv_b_w[l], conv_b_b[l], w_gate_a[l],
              b_gate_a[l], w_gate_x[l], b_gate_x[l], lru_lambda[l], w_rnn_out[l], w_mix_out[l], w_q_x[l],
              w_o_x[l], w_ffn_in[l], w_ffn_out[l])
        mk, mv = mem_kv(mem_prompt, norm_gains[l, 6], w_kv_x[l])
        xp, na, nb, nh = layer(xp, mk, mv, zero_a, zero_b, zero_h, lw)
        pa.append(na); pb.append(nb); ph.append(nh); pk.append(mk); pv.append(mv)
        xs, ma, mb, mh = layer(xs, cache_mem_k[l], cache_mem_v[l], state_conv_a[l], state_conv_b[l],
                               state_rglru[l], lw)
        sa.append(ma); sb.append(mb); sh.append(mh)
    return (xp, xs, jnp.stack(pa), jnp.stack(pb), jnp.stack(ph), jnp.stack(pk), jnp.stack(pv),
            jnp.stack(sa), jnp.stack(sb), jnp.stack(sh))
```

```cpp
#include <hip/hip_runtime.h>
#include <hip/hip_cooperative_groups.h>
#include <cstdio>
#include <cstdint>
namespace cg = cooperative_groups;
#ifndef PHM
#define PHM 0xFFFFFF
#endif
#define CONVA_INTERLEAVE 1
#define REP_S1 1
#define REP_S2 1
#define REP_S3 1
#define REP_PRO 1
#define REP_ATTS 1
#define REP_ROW 1
#define REP_SCAN 1
#define REP_ATTN 1
#define REP_BAR 1
#define REP_MINI 1
namespace pg8 {
#define PG8_LAS __attribute__((address_space(3)))
typedef unsigned short bf16_t;
typedef short bf16x8 __attribute__((ext_vector_type(8)));
typedef float f32x4 __attribute__((ext_vector_type(4)));
typedef unsigned u32x4 __attribute__((ext_vector_type(4)));
constexpr int BM = 256, BK = 64, HALF = 128, HTB = HALF * BK * 2  , STAGE_BYTES = 8 * HTB, NXCD = 8, WGM = 8;

__host__ __device__ __forceinline__ int lds_byte(int r, int c) { const int st = (r >> 4) * 2 + (c >> 5), rr = r & 15, cc = c & 31, ob = rr * 64 + cc * 2; return st * 1024 + (ob ^ (((ob >> 9) & 1) << 5)); }
__host__ __device__ __forceinline__ void stage_rc(int b, int& R, int& C) { const int st = b / 1024, sb = b % 1024, swz = sb ^ (((sb >> 9) & 1) << 5); R = (st >> 1) * 16 + swz / 64; C = (st & 1) * 32 + (swz % 64) / 2; }
__host__ __device__ __forceinline__ int perm32(int rho) { const int n = rho >> 4, i = rho & 15; return 8 * (i >> 2) + 4 * n + (i & 3); }

struct Unit { int pm, pn; };
struct Gemm { const bf16_t* A; const bf16_t* Bt; int M, N, K; };

struct StaticOrder {
    int nM, nN, nwg, G, c;
    __host__ __device__ void init(int M, int N, int G_, int c_) { nM = M / BM; nN = N / BM; nwg = nM * nN; G = G_; c = c_; }
    __host__ __device__ bool next(int i, Unit& u) const {
        const long L = (long)i * G + c; if (L >= nwg) return false;
        int wgid = (int)L; { const int q = nwg / NXCD, r = nwg % NXCD, xcd = wgid % NXCD, off = wgid / NXCD; wgid = (xcd < r ? xcd * (q + 1) : r * (q + 1) + (xcd - r) * q) + off; }
        const int nig = WGM * nN, gid = wgid / nig, fm = gid * WGM, gsz = (nM - fm) < WGM ? (nM - fm) : WGM;
        u.pm = fm + ((wgid % nig) % gsz); u.pn = (wgid % nig) / gsz; return true;
    }
    __device__ __forceinline__ void a_ready(const Unit&) const {}
    __device__ __forceinline__ void done(const Unit&) const {}
};

typedef float f32x2_t __attribute__((ext_vector_type(2))); typedef __bf16 bf16x2_t __attribute__((ext_vector_type(2)));
__device__ __forceinline__ unsigned cvt_pk_bf16(float lo, float hi) { f32x2_t v = {lo, hi}; bf16x2_t b = __builtin_convertvector(v, bf16x2_t); return __builtin_bit_cast(unsigned, b); }
typedef unsigned u32x2 __attribute__((ext_vector_type(2)));
__device__ __forceinline__ float bflo(unsigned w) { return __uint_as_float(w << 16); }
__device__ __forceinline__ float bfhi(unsigned w) { return __uint_as_float(w & 0xffff0000u); }
__device__ __forceinline__ float sigmoidf_(float x) { return __builtin_amdgcn_rcpf(1.0f + __expf(-x)); }
__device__ __forceinline__ void st_bf16x4(bf16_t* p, f32x4 v) { u32x2 w; w.x = cvt_pk_bf16(v[0], v[1]); w.y = cvt_pk_bf16(v[2], v[3]); *(u32x2*)p = w; }
__device__ __forceinline__ f32x4 ld_bf16x4(const bf16_t* p) { const u32x2 w = *(const u32x2*)p; return (f32x4){bflo(w.x), bfhi(w.x), bflo(w.y), bfhi(w.y)}; }

typedef unsigned u32x4e __attribute__((ext_vector_type(4)));
__device__ __forceinline__ void st_bf16x8(bf16_t* p, f32x4 a, f32x4 b) { u32x4e w; w.x = cvt_pk_bf16(a[0], a[1]); w.y = cvt_pk_bf16(a[2], a[3]); w.z = cvt_pk_bf16(b[0], b[1]); w.w = cvt_pk_bf16(b[2], b[3]); *(u32x4e*)p = w; }
__device__ __forceinline__ void ld_bf16x8(const bf16_t* p, f32x4& a, f32x4& b) { const u32x4e w = *(const u32x4e*)p; a = (f32x4){bflo(w.x), bfhi(w.x), bflo(w.y), bfhi(w.y)}; b = (f32x4){bflo(w.z), bfhi(w.z), bflo(w.w), bfhi(w.w)}; }
template <int MODE> struct EpiBf {
    static constexpr bool PERM = true, AFTER_DRAIN = false;
    bf16_t* O; const bf16_t* mul; const bf16_t* add; int ldc;
    __device__ __forceinline__ void apply(int row, int col, f32x4 v) const { const size_t o = (size_t)row * ldc + col;
        if (MODE >= 1) v = v * ld_bf16x4(mul + o);
        if (MODE == 2) v = v + ld_bf16x4(add + o);
        st_bf16x4(O + o, v); }
    __device__ __forceinline__ void operator()(const f32x4 (&acc)[2][2][4][2], const Unit& u, int wr, int wc, int fr, int fq) const {
        const int row0 = u.pm * BM + wr * 64 + fr, col0 = u.pn * BM + wc * 32 + 8 * fq;
#pragma unroll
        for (int ai = 0; ai < 2; ++ai) {
            u32x4e gm[4][2], ga[4][2];
            if (MODE >= 1) {
#pragma unroll
                for (int m = 0; m < 4; ++m)
#pragma unroll
                    for (int bj = 0; bj < 2; ++bj) { const size_t o = (size_t)(row0 + ai * HALF + m * 16) * ldc + col0 + bj * HALF; gm[m][bj] = __builtin_nontemporal_load((const u32x4e*)(mul + o)); if (MODE == 2) ga[m][bj] = __builtin_nontemporal_load((const u32x4e*)(add + o)); } }
#pragma unroll
            for (int m = 0; m < 4; ++m) { const size_t ro = (size_t)(row0 + ai * HALF + m * 16) * ldc + col0;
#pragma unroll
                for (int bj = 0; bj < 2; ++bj) { const size_t o = ro + bj * HALF; f32x4 v0 = acc[ai][bj][m][0], v1 = acc[ai][bj][m][1];
                        if (MODE >= 1) { const u32x4e w = gm[m][bj]; v0 = v0 * (f32x4){bflo(w.x), bfhi(w.x), bflo(w.y), bfhi(w.y)}; v1 = v1 * (f32x4){bflo(w.z), bfhi(w.z), bflo(w.w), bfhi(w.w)}; }
                        if (MODE == 2) { const u32x4e w = ga[m][bj]; v0 = v0 + (f32x4){bflo(w.x), bfhi(w.x), bflo(w.y), bfhi(w.y)}; v1 = v1 + (f32x4){bflo(w.z), bfhi(w.z), bflo(w.w), bfhi(w.w)}; }
                        st_bf16x8(O + o, v0, v1); } }
            if (MODE >= 1) asm volatile("" ::: "memory"); }
    }
};
struct EpiF32 {
    static constexpr bool PERM = false, AFTER_DRAIN = false;
    float* O; int ldc;
    __device__ __forceinline__ void apply(int row, int col, f32x4 v) const { *(f32x4*)(O + (size_t)row * ldc + col) = v; }
    __device__ __forceinline__ void operator()(const f32x4 (&acc)[2][2][4][2], const Unit& u, int wr, int wc, int fr, int fq) const {
        const int row0 = u.pm * BM + wr * 64 + fr, col0 = u.pn * BM + wc * 32 + 4 * fq;
#pragma unroll
        for (int ai = 0; ai < 2; ++ai)
#pragma unroll
            for (int m = 0; m < 4; ++m) { const size_t ro = (size_t)(row0 + ai * HALF + m * 16) * ldc + col0;
#pragma unroll
                for (int bj = 0; bj < 2; ++bj)
#pragma unroll
                    for (int n = 0; n < 2; ++n) *(f32x4*)(O + ro + bj * HALF + n * 16) = acc[ai][bj][m][n]; }
    }
};
struct EpiInProj {
    static constexpr bool PERM = true, AFTER_DRAIN = false;
    bf16_t* P; size_t slot;
    __device__ __forceinline__ void operator()(const f32x4 (&acc)[2][2][4][2], const Unit& u, int wr, int wc, int fr, int fq) const {
        const int row0 = u.pm * BM + wr * 64 + fr; const int pn = u.pn;
        if (pn >= 4 && pn < 12) {
            bf16_t* base = P + slot; const int col0 = (pn - 4) * HALF + wc * 32 + 8 * fq;
#pragma unroll
            for (int ai = 0; ai < 2; ++ai)
#pragma unroll
                for (int m = 0; m < 4; ++m) { const size_t ro = (size_t)(row0 + ai * HALF + m * 16) * 1024 + col0;
                    st_bf16x8(base + ro, acc[ai][0][m][0] * acc[ai][1][m][0], acc[ai][0][m][1] * acc[ai][1][m][1]); }
        } else {
            int s, ct; if (pn < 4) { s = 0; ct = pn; } else if (pn < 16) { s = 2; ct = pn - 12; } else if (pn < 20) { s = 3; ct = pn - 16; } else { s = 4; ct = pn - 20; }
            bf16_t* base = P + (size_t)s * slot; const int col0 = ct * BM + wc * 32 + 8 * fq; const bool sg = (s >= 3);
#pragma unroll
            for (int ai = 0; ai < 2; ++ai)
#pragma unroll
                for (int m = 0; m < 4; ++m) { const size_t ro = (size_t)(row0 + ai * HALF + m * 16) * 1024 + col0;
#pragma unroll
                    for (int bj = 0; bj < 2; ++bj) { f32x4 v0 = acc[ai][bj][m][0], v1 = acc[ai][bj][m][1];
                            if (sg) {
#pragma unroll
                                for (int i = 0; i < 4; ++i) { v0[i] = sigmoidf_(v0[i]); v1[i] = sigmoidf_(v1[i]); } }
                            st_bf16x8(base + ro + bj * HALF, v0, v1); } }
        }
    }
};
struct EpiSwiGLU {
    static constexpr bool PERM = true, AFTER_DRAIN = false;
    bf16_t* O; int ldc;
    __device__ __forceinline__ void operator()(const f32x4 (&acc)[2][2][4][2], const Unit& u, int wr, int wc, int fr, int fq) const {
        const int row0 = u.pm * BM + wr * 64 + fr, col0 = u.pn * HALF + wc * 32 + 8 * fq;
#pragma unroll
        for (int ai = 0; ai < 2; ++ai)
#pragma unroll
            for (int m = 0; m < 4; ++m) { const size_t ro = (size_t)(row0 + ai * HALF + m * 16) * ldc + col0; f32x4 v[2];
#pragma unroll
                for (int n = 0; n < 2; ++n) { const f32x4 g = acc[ai][0][m][n], up = acc[ai][1][m][n];
#pragma unroll
                    for (int i = 0; i < 4; ++i) v[n][i] = g[i] * sigmoidf_(g[i]) * up[i]; }
                st_bf16x8(O + ro, v[0], v[1]); }
    }
};
struct EpiMemKV {
    static constexpr bool PERM = false, AFTER_DRAIN = false;
    float* outK; float* outV; bf16_t* KB; bf16_t* VT;
    __device__ __forceinline__ void operator()(const f32x4 (&acc)[2][2][4][2], const Unit& u, int wr, int wc, int fr, int fq) const {
        const int row0 = u.pm * BM + wr * 64 + fr; const bool isv = (u.pn >= 4); const int col0 = (u.pn & 3) * BM + wc * 32 + 4 * fq;
        float* of = isv ? outV : outK;
#pragma unroll
        for (int ai = 0; ai < 2; ++ai)
#pragma unroll
            for (int m = 0; m < 4; ++m) { const int row = row0 + ai * HALF + m * 16; const size_t ro = (size_t)row * 1024 + col0;
#pragma unroll
                for (int bj = 0; bj < 2; ++bj)
#pragma unroll
                    for (int n = 0; n < 2; ++n) { const f32x4 v = acc[ai][bj][m][n]; const size_t o = ro + bj * HALF + n * 16;
                        __builtin_nontemporal_store(v, (f32x4*)(of + o));
                        if (!isv) st_bf16x4(KB + o, v);
                        else { const int c = col0 + bj * HALF + n * 16; const int b = row >> 8, mm = row & 255;
                            bf16_t* vt = VT + ((size_t)(b * 1024 + c)) * 256 + mm;
                            const unsigned w0 = cvt_pk_bf16(v[0], v[1]), w1 = cvt_pk_bf16(v[2], v[3]);
                            vt[0] = (bf16_t)(w0 & 0xffffu); vt[256] = (bf16_t)(w0 >> 16); vt[512] = (bf16_t)(w1 & 0xffffu); vt[768] = (bf16_t)(w1 >> 16); } } }
    }
};

template <class Epi, class Sched, bool ALIGN_EPI = false, bool SP2 = false>
__device__ __forceinline__ void gemm_phase(PG8_LAS unsigned char* lds, const Gemm g, const Sched& S, const Epi& E) {
    int tid_o = threadIdx.x; asm volatile("" : "+v"(tid_o));
    const int tid = tid_o, wid = __builtin_amdgcn_readfirstlane(tid >> 6), lane = tid & 63, wr = wid >> 2, wc = wid & 3, fr = lane & 15, fq = lane >> 4;
    const int K = g.K, nt = K / BK;
    unsigned voffA[2], voffB[2];
#pragma unroll
    for (int i = 0; i < 2; ++i) { int R, C; stage_rc(tid * 16 + i * 8192, R, C); const int Rb = Epi::PERM ? ((R & ~31) + perm32(R & 31)) : R;
        voffA[i] = (unsigned)(R * K + C) * 2u; voffB[i] = (unsigned)(Rb * K + C) * 2u; }
    const size_t kstep = (size_t)(BK * 2);
    const size_t hstep = (size_t)HALF * K * 2;
    const size_t tstep = 2 * hstep;
    const unsigned ldsw = (unsigned)wid * 1024u;
    const int aoff = lds_byte(wr * 64 + fr, fq * 8), boff = lds_byte(wc * 32 + fr, fq * 8);
#define PG8_SA(b, h) (((b) * 2 + (h)) * HTB)
#define PG8_SB(b, h) ((4 + (b) * 2 + (h)) * HTB)
#define PG8_STAGE(bufoff, gbase, voff) do { _Pragma("unroll") for (int _i = 0; _i < 2; ++_i) \
        __builtin_amdgcn_global_load_lds((const unsigned*)((const char*)(gbase) + (voff)[_i]), (PG8_LAS unsigned*)(lds + (bufoff) + ldsw + _i * 8192), 16, 0, 0); } while (0)
#define PG8_LDA(dst, b, h) do { _Pragma("unroll") for (int m = 0; m < 4; ++m) _Pragma("unroll") for (int k = 0; k < 2; ++k) dst[m][k] = *(const PG8_LAS bf16x8*)(lds + PG8_SA(b, h) + aoff + m * 2048 + k * 1024); } while (0)
#define PG8_LDB(dst, b, h) do { _Pragma("unroll") for (int n = 0; n < 2; ++n) _Pragma("unroll") for (int k = 0; k < 2; ++k) dst[n][k] = *(const PG8_LAS bf16x8*)(lds + PG8_SB(b, h) + boff + n * 2048 + k * 1024); } while (0)
#define PG8_MMA(ai, bj, At, Bt) do { __builtin_amdgcn_s_setprio(1); _Pragma("unroll") for (int m = 0; m < 4; ++m) _Pragma("unroll") for (int n = 0; n < 2; ++n) _Pragma("unroll") for (int k = 0; k < 2; ++k) \
        acc[ai][bj][m][n] = __builtin_amdgcn_mfma_f32_16x16x32_bf16(Bt[n][k], At[m][k], acc[ai][bj][m][n], 0, 0, 0); __builtin_amdgcn_s_setprio(0); } while (0)
#define PG8_WAIT_V(n) asm volatile("s_waitcnt vmcnt(" #n ")" ::: "memory")
#define PG8_WAIT_L(n) asm volatile("s_waitcnt lgkmcnt(" #n ")" ::: "memory")
#define PG8_BAR __builtin_amdgcn_s_barrier()
#define PG8_SCHED __builtin_amdgcn_sched_barrier(0)
    Unit cur, nxt; int ui = 0;
    if (!S.next(0, cur)) return;
    f32x4 acc[2][2][4][2];
#pragma unroll
    for (int a = 0; a < 2; ++a)
#pragma unroll
        for (int b = 0; b < 2; ++b)
#pragma unroll
            for (int m = 0; m < 4; ++m)
#pragma unroll
                for (int n = 0; n < 2; ++n) acc[a][b][m][n] = (f32x4){0.f, 0.f, 0.f, 0.f};
    bf16x8 At[4][2], B0[2][2], B1[2][2];
    const char* cA = (const char*)g.A + (size_t)cur.pm * tstep; const char* cB = (const char*)g.Bt + (size_t)cur.pn * tstep;
    S.a_ready(cur);
    if constexpr (SP2) {
        PG8_STAGE(PG8_SB(0, 0), cB, voffB); PG8_STAGE(PG8_SB(0, 1), cB + hstep, voffB); PG8_STAGE(PG8_SA(0, 0), cA, voffA); PG8_STAGE(PG8_SA(0, 1), cA + hstep, voffA);
        if (wr == 1) PG8_BAR;
        PG8_WAIT_V(2); PG8_BAR;
        PG8_STAGE(PG8_SB(1, 0), cB + kstep, voffB); PG8_STAGE(PG8_SA(1, 0), cA + kstep, voffA); PG8_STAGE(PG8_SB(1, 1), cB + hstep + kstep, voffB);
        PG8_WAIT_V(6); PG8_BAR;
    } else {
        PG8_STAGE(PG8_SB(0, 0), cB, voffB); PG8_STAGE(PG8_SA(0, 0), cA, voffA); PG8_STAGE(PG8_SB(0, 1), cB + hstep, voffB); PG8_STAGE(PG8_SA(0, 1), cA + hstep, voffA);
        if (wr == 1) PG8_BAR;
        PG8_WAIT_V(4); PG8_BAR;
        PG8_STAGE(PG8_SB(1, 0), cB + kstep, voffB); PG8_STAGE(PG8_SA(1, 0), cA + kstep, voffA); PG8_STAGE(PG8_SB(1, 1), cB + hstep + kstep, voffB);
        PG8_WAIT_V(6); PG8_BAR;
    }
    for (;;) {
        const bool has_next = S.next(ui + 1, nxt);
        const char* nA = has_next ? (const char*)g.A + (size_t)nxt.pm * tstep : cA; const char* nB = has_next ? (const char*)g.Bt + (size_t)nxt.pn * tstep : cB;
        for (int t = 0; t < nt; t += 2) {
            const bool last = (t == nt - 2);
            const char* a1 = cA + (size_t)(t + 1) * kstep;
            const char* a2 = last ? nA : cA + (size_t)(t + 2) * kstep; const char* b2 = last ? nB : cB + (size_t)(t + 2) * kstep;
            const char* a3 = a2 + kstep; const char* b3 = b2 + kstep;
            if (last && has_next) S.a_ready(nxt);
            if constexpr (SP2) {
            PG8_LDB(B0, 0, 0); PG8_LDB(B1, 0, 1); PG8_SCHED; PG8_LDA(At, 0, 0); PG8_STAGE(PG8_SA(1, 1), a1 + hstep, voffA);
            PG8_WAIT_V(8); PG8_WAIT_L(0); PG8_BAR; PG8_MMA(0, 0, At, B0); PG8_MMA(0, 1, At, B1); PG8_BAR; PG8_SCHED;
            PG8_LDA(At, 0, 1); PG8_STAGE(PG8_SB(0, 0), b2, voffB); PG8_STAGE(PG8_SB(0, 1), b2 + hstep, voffB); PG8_STAGE(PG8_SA(0, 0), a2, voffA);
            PG8_WAIT_V(8); PG8_WAIT_L(0); PG8_BAR; PG8_MMA(1, 0, At, B0); PG8_MMA(1, 1, At, B1); PG8_BAR; PG8_SCHED;
            PG8_LDB(B0, 1, 0); PG8_LDB(B1, 1, 1); PG8_SCHED; PG8_LDA(At, 1, 0); PG8_STAGE(PG8_SA(0, 1), a2 + hstep, voffA);
            PG8_WAIT_V(8); PG8_WAIT_L(0); PG8_BAR; PG8_MMA(0, 0, At, B0); PG8_MMA(0, 1, At, B1); PG8_BAR; PG8_SCHED;
            PG8_LDA(At, 1, 1); PG8_STAGE(PG8_SB(1, 0), b3, voffB); PG8_STAGE(PG8_SB(1, 1), b3 + hstep, voffB); PG8_STAGE(PG8_SA(1, 0), a3, voffA);
            PG8_WAIT_V(8); PG8_WAIT_L(0); PG8_BAR; PG8_MMA(1, 0, At, B0); PG8_MMA(1, 1, At, B1); PG8_BAR; PG8_SCHED;
            } else {
            PG8_LDB(B0, 0, 0); PG8_SCHED; PG8_LDA(At, 0, 0); PG8_STAGE(PG8_SA(1, 1), a1 + hstep, voffA);
            PG8_WAIT_L(8); PG8_BAR; PG8_WAIT_L(0); PG8_MMA(0, 0, At, B0); PG8_BAR; PG8_SCHED;
            PG8_LDB(B1, 0, 1); PG8_STAGE(PG8_SB(0, 0), b2, voffB);
            PG8_BAR; PG8_WAIT_L(0); PG8_MMA(0, 1, At, B1); PG8_BAR;
            PG8_LDA(At, 0, 1); PG8_STAGE(PG8_SA(0, 0), a2, voffA);
            PG8_BAR; PG8_WAIT_L(0); PG8_MMA(1, 0, At, B0); PG8_BAR; PG8_SCHED;
            PG8_STAGE(PG8_SB(0, 1), b2 + hstep, voffB);
            PG8_WAIT_V(6); PG8_BAR; PG8_MMA(1, 1, At, B1); PG8_BAR;
            PG8_LDB(B0, 1, 0); PG8_SCHED; PG8_LDA(At, 1, 0); PG8_STAGE(PG8_SA(0, 1), a2 + hstep, voffA);
            PG8_WAIT_L(8); PG8_BAR; PG8_WAIT_L(0); PG8_MMA(0, 0, At, B0); PG8_BAR; PG8_SCHED;
            PG8_LDB(B1, 1, 1); PG8_STAGE(PG8_SB(1, 0), b3, voffB);
            PG8_BAR; PG8_WAIT_L(0); PG8_MMA(0, 1, At, B1); PG8_BAR;
            PG8_LDA(At, 1, 1); PG8_STAGE(PG8_SA(1, 0), a3, voffA);
            PG8_BAR; PG8_WAIT_L(0); PG8_MMA(1, 0, At, B0); PG8_BAR; PG8_SCHED;
            PG8_STAGE(PG8_SB(1, 1), b3 + hstep, voffB);
            PG8_WAIT_V(6); PG8_BAR; PG8_MMA(1, 1, At, B1); PG8_BAR;
            }
        }
        if constexpr (ALIGN_EPI) { if (wr == 0) PG8_BAR; }
        if constexpr (!Epi::AFTER_DRAIN) { E(acc, cur, wr, wc, fr, fq); S.done(cur); }
        if (!has_next) break;
#pragma unroll
        for (int a = 0; a < 2; ++a)
#pragma unroll
            for (int b = 0; b < 2; ++b)
#pragma unroll
                for (int m = 0; m < 4; ++m)
#pragma unroll
                    for (int n = 0; n < 2; ++n) acc[a][b][m][n] = (f32x4){0.f, 0.f, 0.f, 0.f};
        cur = nxt; cA = nA; cB = nB; ++ui;
        if constexpr (ALIGN_EPI) { if (wr == 1) PG8_BAR; }
    }
    PG8_WAIT_V(0);
    if constexpr (!ALIGN_EPI) { if (wr == 0) PG8_BAR; }
    PG8_BAR;
    if constexpr (Epi::AFTER_DRAIN) { E.fused(acc, cur, wr, wc, fr, fq, lds, wid, lane); S.done(cur); }
#undef PG8_SA
#undef PG8_SB
#undef PG8_STAGE
#undef PG8_LDA
#undef PG8_LDB
#undef PG8_MMA
#undef PG8_WAIT_V
#undef PG8_WAIT_L
#undef PG8_BAR
#undef PG8_SCHED
}
}

constexpr int NWAVES = 8;
constexpr int DM = 1024, NB = 8, SEQ = 2048, DEPTH = 2, DB = 128, DSEQ = 8, NMEM = 256, NH = 4, HD = 256, DFF = 2816, DIN = 6144;
constexpr int MP = NB * SEQ, MS = DB * DSEQ, MT = MP + MS;
constexpr int MROWS = NB * NMEM;
constexpr float EPS = 1e-6f;
constexpr size_t MiB = 1u << 20;
constexpr size_t WS_CTL = 0, CTL_ZERO_BYTES = 20 * 1024;
constexpr size_t WS_W = 2 * MiB, W_LAYER = 44 * MiB;
constexpr size_t WO_IN = 0, WO_CO = 12 * MiB, WO_RO = 14 * MiB, WO_MIX = 16 * MiB, WO_KV = 18 * MiB, WO_Q = 22 * MiB, WO_O = 24 * MiB, WO_FI = 26 * MiB, WO_FO = 37 * MiB;
constexpr size_t WS_XN = 92 * MiB;
constexpr size_t WS_MN = 128 * MiB;
constexpr size_t WS_PROJ = 138 * MiB;
constexpr size_t WS_CA = 310 * MiB, WS_HS = 346 * MiB, WS_YC = 382 * MiB, WS_Z = 418 * MiB;
constexpr size_t WS_T = 454 * MiB, WS_X = 524 * MiB;
constexpr size_t WS_Q = 594 * MiB, WS_O = 630 * MiB;
constexpr size_t WS_ACT = 666 * MiB;
constexpr size_t WS_MKB = 762 * MiB, WS_MVT = 772 * MiB;
constexpr size_t WS_END = 782 * MiB;
constexpr size_t SLOT = (size_t)MT * DM;
constexpr size_t OFF_Y = 0, OFF_PCA = (size_t)MT * DM, OFF_PCB = OFF_PCA + 2 * 8 * 2 * 1024, OFF_PH = OFF_PCB + 2 * 8 * 3 * 1024, OFF_PK = OFF_PH + 2 * 8 * 1024,
                 OFF_PV = OFF_PK + (size_t)2 * MROWS * DM, OFF_SA = OFF_PV + (size_t)2 * MROWS * DM, OFF_SB = OFF_SA + 2 * 128 * 2 * 1024, OFF_SH = OFF_SB + 2 * 128 * 3 * 1024,
                 OUT_TOTAL = OFF_SH + 2 * 128 * 1024;
constexpr int CW_BAR = 1024;
constexpr int LDS_BYTES = 147456;
constexpr int MISC_OFF = 146432;

#define GAS __attribute__((address_space(1)))
#define LAS __attribute__((address_space(3)))
typedef unsigned short bf16;
typedef unsigned v4u __attribute__((ext_vector_type(4)));
typedef unsigned v2u __attribute__((ext_vector_type(2)));
typedef float f32x4 __attribute__((ext_vector_type(4)));
typedef short bf16x8 __attribute__((ext_vector_type(8)));
#define LDS_WAIT() asm volatile("s_waitcnt lgkmcnt(0)" ::: "memory")
using pg8::cvt_pk_bf16; using pg8::bflo; using pg8::bfhi; using pg8::sigmoidf_;
__device__ __forceinline__ float wave_sum(float v) {
#pragma unroll
    for (int o = 1; o < 64; o <<= 1) v += __shfl_xor(v, o);
    return v;
}
#define XB_TMO      128
#define XB_XCNT(j)  (256  + 64 * (j))
#define XB_XSUB(j)  (1280 + 64 * (j))
#define XB_XGEN(j)  (2304 + 64 * (j))
#define XB_TOP      3328
#define XB_TOPGEN   3392
#define XCD_BAR_WORDS 3456
#define XB_SPIN_CAP (1u << 18)

__device__ __forceinline__ unsigned xb_ld(unsigned* p)              { return __hip_atomic_load(p, __ATOMIC_RELAXED, __HIP_MEMORY_SCOPE_AGENT); }
__device__ __forceinline__ unsigned xb_add(unsigned* p, unsigned v) { return __hip_atomic_fetch_add(p, v, __ATOMIC_RELAXED, __HIP_MEMORY_SCOPE_AGENT); }
__device__ __forceinline__ unsigned xb_xcc_id() { return (unsigned)__builtin_amdgcn_s_getreg((3 << 11) | 20) & 0xFu; }
#define XB_SPIN(cond, bar) do { unsigned _sp = 0; while (cond) { __builtin_amdgcn_s_sleep(1); \
    if ((++_sp & 255u) == 0u) { if (xb_ld(&(bar)[XB_TMO])) break; if (_sp > XB_SPIN_CAP) { atomicAdd(&(bar)[XB_TMO], 1u); break; } } } } while (0)

struct XcdBarrier {
    unsigned* bar; unsigned x;
    volatile LAS unsigned* st;
};

__device__ __forceinline__ XcdBarrier xcd_barrier_post(unsigned* bar, volatile LAS unsigned* st) {
    XcdBarrier b; b.bar = bar; b.x = xb_xcc_id(); b.st = st;
    if (threadIdx.x == 0) (void)xb_add(&bar[XB_XCNT(b.x)], 1u);
    return b;
}
__device__ __forceinline__ void xcd_barrier_complete(unsigned* bar, unsigned x, unsigned& nloc, unsigned& nx) {
    const unsigned G = gridDim.x * gridDim.y * gridDim.z;
    unsigned sum, cnt, mine, sp = 0u;
    for (;;) {
        sum = 0u; cnt = 0u; mine = 0u;
#pragma unroll
        for (unsigned j = 0; j < 16; ++j) { const unsigned c = xb_ld(&bar[XB_XCNT(j)]); sum += c; cnt += (c > 0u) ? 1u : 0u; mine = (j == x) ? c : mine; }
        if (sum == G) break;
        __builtin_amdgcn_s_sleep(1);
        if ((++sp & 255u) == 0u) { if (xb_ld(&bar[XB_TMO])) break; if (sp > XB_SPIN_CAP) { atomicAdd(&bar[XB_TMO], 1u); break; } }
    }
    nloc = mine > 0u ? mine : 1u; nx = cnt > 0u ? cnt : 1u;
}

__device__ __forceinline__ void xcd_barrier(const XcdBarrier& b) {
    asm volatile("s_waitcnt vmcnt(0)" ::: "memory");
    __syncthreads();
    if (threadIdx.x == 0) {
        unsigned* bar = b.bar;
        __builtin_amdgcn_s_waitcnt(0);
        unsigned nloc = b.st[0], nx = b.st[1];
        if (nloc == 0u) { xcd_barrier_complete(bar, b.x, nloc, nx); b.st[0] = nloc; b.st[1] = nx; }
        const unsigned old = xb_add(&bar[XB_XSUB(b.x)], 1u);
        const unsigned gen = old / nloc;
        if (old + 1u == (gen + 1u) * nloc) {
            __builtin_amdgcn_fence(__ATOMIC_RELEASE, "agent");
            asm volatile("s_waitcnt vmcnt(0)" ::: "memory");
            const unsigned og = xb_add(&bar[XB_TOP], 1u);
            const unsigned tg = og / nx;
            if (og + 1u == (tg + 1u) * nx) xb_add(&bar[XB_TOPGEN], 1u);
            else XB_SPIN(xb_ld(&bar[XB_TOPGEN]) == tg, bar);
            __builtin_amdgcn_fence(__ATOMIC_ACQUIRE, "agent");
            xb_add(&bar[XB_XGEN(b.x)], 1u);
            asm volatile("s_waitcnt vmcnt(0)" ::: "memory");
        } else {
            XB_SPIN(xb_ld(&bar[XB_XGEN(b.x)]) == gen, bar);
            __builtin_amdgcn_fence(__ATOMIC_ACQUIRE, "agent");
            asm volatile("s_waitcnt vmcnt(0)" ::: "memory");
        }
    }
    __syncthreads();
}

__device__ __forceinline__ int map_row(int mapid, int n) {
    if (mapid == 1) { const int seg = n >> 10, c = n & 1023;
        if (seg == 0) return c; if (seg == 1) return 1024 + (c >> 7) * 256 + (c & 127); if (seg == 2) return 1024 + (c >> 7) * 256 + 128 + (c & 127);
        return 3072 + (seg - 3) * 1024 + c; }
    if (mapid == 2) { if (n < DFF) return (n >> 7) * 256 + (n & 127); const int c = n - DFF; return (c >> 7) * 256 + 128 + (c & 127); }
    return n;
}
__device__ __forceinline__ void transpose_item(const float* W, int K, int N, bf16* WT, int mapid, LAS float* scr, int item, int lane) {
    const int nblk = N / 32, kb = item / nblk, nb = item % nblk, k0 = 64 * kb, n0 = 32 * nb;
#pragma unroll 8
    for (int i = 0; i < 32; ++i) { const int kk = 2 * i + (lane >> 5); scr[kk * 33 + (lane & 31)] = __builtin_nontemporal_load(W + (size_t)(k0 + kk) * N + n0 + (lane & 31)); }
    LDS_WAIT(); asm volatile("" ::: "memory");
    const int c = lane & 7; const int r0 = map_row(mapid, n0);
#pragma unroll
    for (int j = 0; j < 4; ++j) { const int n = (lane >> 3) + 8 * j; const LAS float* s = scr + (8 * c) * 33 + n;
        v4u o; o.x = cvt_pk_bf16(s[0 * 33], s[1 * 33]); o.y = cvt_pk_bf16(s[2 * 33], s[3 * 33]); o.z = cvt_pk_bf16(s[4 * 33], s[5 * 33]); o.w = cvt_pk_bf16(s[6 * 33], s[7 * 33]);
        *(v4u*)(WT + (size_t)(r0 + n) * K + k0 + 8 * c) = o; }
    LDS_WAIT(); asm volatile("" ::: "memory");
}
__device__ __forceinline__ void rms_row_to_bf16(const float* xrow, const float* g, bf16* orow, int lane) {
    const f32x4* xr = (const f32x4*)xrow + lane; const f32x4* gr = (const f32x4*)g + lane;
    f32x4 v[4]; float s = 0.f;
#pragma unroll
    for (int j = 0; j < 4; ++j) { v[j] = xr[64 * j]; s += (v[j].x * v[j].x + v[j].y * v[j].y) + (v[j].z * v[j].z + v[j].w * v[j].w); }
    const float rs = 1.0f / sqrtf(wave_sum(s) * (1.f / DM) + EPS);
    v2u* o8 = (v2u*)orow + lane;
#pragma unroll
    for (int j = 0; j < 4; ++j) { const f32x4 gg = gr[64 * j]; v2u w; w.x = cvt_pk_bf16(v[j].x * rs * gg.x, v[j].y * rs * gg.y); w.y = cvt_pk_bf16(v[j].z * rs * gg.z, v[j].w * rs * gg.w); o8[64 * j] = w; }
}
template <bool XIN_BF, bool XOUT_BF> __device__ __forceinline__ void row_phase(const bf16* T, const void* xinA, const void* xinB, void* xout, const float* gpost, const float* gpre, bf16* XN, int gw_, int NGW_, int lane_) {
    asm volatile("" : "+v"(lane_));
    f32x4 gp[4], gn[4];
#pragma unroll
    for (int j = 0; j < 4; ++j) { gp[j] = ((const f32x4*)gpost)[lane_ + 64 * j]; gn[j] = gpre ? ((const f32x4*)gpre)[lane_ + 64 * j] : (f32x4){0.f, 0.f, 0.f, 0.f}; }
    for (int r = gw_; r < MT; r += NGW_) {
        const v2u* tr = (const v2u*)(T + (size_t)r * DM) + lane_;
        f32x4 t[4], x[4]; float s = 0.f;
#pragma unroll
        for (int j = 0; j < 4; ++j) { const v2u w = __builtin_nontemporal_load(tr + 64 * j); t[j] = (f32x4){bflo(w.x), bfhi(w.x), bflo(w.y), bfhi(w.y)}; s += (t[j].x * t[j].x + t[j].y * t[j].y) + (t[j].z * t[j].z + t[j].w * t[j].w); }
        if (XIN_BF) { const v2u* xr = (const v2u*)((const bf16*)xinA + (size_t)r * DM) + lane_;
#pragma unroll
            for (int j = 0; j < 4; ++j) { const v2u w = __builtin_nontemporal_load(xr + 64 * j); x[j] = (f32x4){bflo(w.x), bfhi(w.x), bflo(w.y), bfhi(w.y)}; } }
        else { const f32x4* xr = (const f32x4*)((r < MP) ? (const float*)xinA + (size_t)r * DM : (const float*)xinB + (size_t)(r - MP) * DM) + lane_;
#pragma unroll
            for (int j = 0; j < 4; ++j) x[j] = xr[64 * j]; }
        const float rs = 1.0f / sqrtf(wave_sum(s) * (1.f / DM) + EPS);
        float s2 = 0.f;
#pragma unroll
        for (int j = 0; j < 4; ++j) { x[j] = x[j] + t[j] * rs * gp[j]; s2 += (x[j].x * x[j].x + x[j].y * x[j].y) + (x[j].z * x[j].z + x[j].w * x[j].w); }
        if (XOUT_BF) { v2u* xo = (v2u*)((bf16*)xout + (size_t)r * DM) + lane_;
#pragma unroll
            for (int j = 0; j < 4; ++j) { v2u w; w.x = cvt_pk_bf16(x[j].x, x[j].y); w.y = cvt_pk_bf16(x[j].z, x[j].w); __builtin_nontemporal_store(w, xo + 64 * j); } }
        else { f32x4* xo = (f32x4*)((float*)xout + (size_t)r * DM) + lane_;
#pragma unroll
            for (int j = 0; j < 4; ++j) __builtin_nontemporal_store(x[j], xo + 64 * j); }
        if (XN) { const float rs2 = 1.0f / sqrtf(wave_sum(s2) * (1.f / DM) + EPS); v2u* o8 = (v2u*)(XN + (size_t)r * DM) + lane_;
#pragma unroll
            for (int j = 0; j < 4; ++j) { v2u w; w.x = cvt_pk_bf16(x[j].x * rs2 * gn[j].x, x[j].y * rs2 * gn[j].y); w.y = cvt_pk_bf16(x[j].z * rs2 * gn[j].z, x[j].w * rs2 * gn[j].w); o8[64 * j] = w; } }
    }
}

struct LayerIn { const float *sca, *scb, *sh, *caw, *cbw, *cbb, *wga, *bga, *wgx, *bgx, *lam; };
__device__ __forceinline__ float fsig(float x) { return __builtin_amdgcn_rcpf(1.0f + __expf(-x)); }
struct ConvA { const bf16* HB; const bf16* G; bf16* CA; float* pca; float* sa; };
__device__ __forceinline__ void bf8_to_f(const v4u w, float* g) { g[0] = bflo(w.x); g[1] = bfhi(w.x); g[2] = bflo(w.y); g[3] = bfhi(w.y); g[4] = bflo(w.z); g[5] = bfhi(w.z); g[6] = bflo(w.w); g[7] = bfhi(w.w); }
struct ConvAReg { v4u w0, wh, w1, w2; };
__device__ __forceinline__ void conva_load(const ConvA& C, int it, ConvAReg& R) {
        const int r = it >> 7, c = (it & 127) * 8;
        const int t = (r < MP) ? (r & (SEQ - 1)) : ((r - MP) & 7);
        R.w0 = *(const v4u*)(C.G + (size_t)r * DM + c); R.wh = *(const v4u*)(C.HB + (size_t)r * DM + c);
        R.w1 = *(const v4u*)(C.G + (size_t)(r - (t >= 1 ? 1 : 0)) * DM + c); R.w2 = *(const v4u*)(C.G + (size_t)(r - (t >= 2 ? 2 : 0)) * DM + c);
}
__device__ __forceinline__ void conva_finish(const ConvA& C, const LayerIn& L, int it, const ConvAReg& R) {
        const int r = it >> 7, c = (it & 127) * 8;
        int t, b, TL; const bool smp = (r >= MP);
        if (!smp) { t = r & (SEQ - 1); b = r >> 11; TL = SEQ; } else { const int s = r - MP; t = s & 7; b = s >> 3; TL = DSEQ; }
        float g0[8], g1[8], g2[8], hb[8];
        bf8_to_f(R.w0, g0); bf8_to_f(R.wh, hb); bf8_to_f(R.w1, g1); bf8_to_f(R.w2, g2);
        if (t < 2) {
            if (smp) { const float* p2 = L.sca + ((size_t)b * 2 + t) * DM + c;
#pragma unroll
                for (int i = 0; i < 8; ++i) g2[i] = p2[i];
                if (t < 1) { const float* p1 = L.sca + ((size_t)b * 2 + 1) * DM + c;
#pragma unroll
                    for (int i = 0; i < 8; ++i) g1[i] = p1[i]; } }
            else {
#pragma unroll
                for (int i = 0; i < 8; ++i) { g2[i] = 0.f; if (t < 1) g1[i] = 0.f; } }
        }
        const f32x4 c0a = *(const f32x4*)(L.caw + c), c0b = *(const f32x4*)(L.caw + c + 4), c1a = *(const f32x4*)(L.caw + DM + c), c1b = *(const f32x4*)(L.caw + DM + c + 4), c2a = *(const f32x4*)(L.caw + 2 * DM + c), c2b = *(const f32x4*)(L.caw + 2 * DM + c + 4);
        float y[8];
#pragma unroll
        for (int i = 0; i < 8; ++i) { const float k0 = i < 4 ? c0a[i & 3] : c0b[i & 3], k1 = i < 4 ? c1a[i & 3] : c1b[i & 3], k2 = i < 4 ? c2a[i & 3] : c2b[i & 3]; y[i] = hb[i] * (k0 * g2[i] + k1 * g1[i] + k2 * g0[i]); }
        v4u o; o.x = cvt_pk_bf16(y[0], y[1]); o.y = cvt_pk_bf16(y[2], y[3]); o.z = cvt_pk_bf16(y[4], y[5]); o.w = cvt_pk_bf16(y[6], y[7]);
        *(v4u*)(C.CA + (size_t)r * DM + c) = o;
        if (t >= TL - 2) { float* dst = (smp ? C.sa : C.pca) + ((size_t)b * 2 + (t - (TL - 2))) * DM + c;
            *(f32x4*)dst = (f32x4){g0[0], g0[1], g0[2], g0[3]}; *(f32x4*)(dst + 4) = (f32x4){g0[4], g0[5], g0[6], g0[7]}; }
}
__device__ __forceinline__ void conva_item(const ConvA& C, const LayerIn& L, int it) { ConvAReg R; conva_load(C, it, R); conva_finish(C, L, it, R); }

constexpr int SC_UE = 0;
constexpr int SC_UCB = 45056;
constexpr int SC_UCF = 63488;
constexpr int SC_AA = 81920;
constexpr int SC_BB = 98304;
constexpr int SC_SEGA = 114688;
constexpr int SC_SEGB = 116736;
constexpr int SC_HIN = 118784;
constexpr int SC_HOUT = 120832;
constexpr int SC_WGT = 129024;
__device__ __forceinline__ void scan_unit(LAS unsigned char* lds, const bf16* U, bf16* HS, const LayerIn& L, float* pcb, float* ph, float* sb, float* sh, int kind, int sidx, int cgi, const ConvA& CV, int& cv_it, int cv_stride) {
    int tid_ = threadIdx.x; asm volatile("" : "+v"(tid_));
    const int tid = tid_, lane = tid & 63, w = tid >> 6, fr = lane & 15, fq = lane >> 4;
    const int nblk = cgi >> 1, cgh = cgi & 1, c0 = nblk * 64, cm0 = c0 + 32 * cgh;
    LAS float* UE = (LAS float*)(lds + SC_UE); LAS bf16* UCB = (LAS bf16*)(lds + SC_UCB); LAS float* UCF = (LAS float*)(lds + SC_UCF);
    LAS float* AA = (LAS float*)(lds + SC_AA); LAS float* BB = (LAS float*)(lds + SC_BB); LAS float* SEGA = (LAS float*)(lds + SC_SEGA);
    LAS float* SEGB = (LAS float*)(lds + SC_SEGB); LAS float* HIN = (LAS float*)(lds + SC_HIN); LAS bf16* HOUT = (LAS bf16*)(lds + SC_HOUT);
    LAS v4u* WGT = (LAS v4u*)(lds + SC_WGT);
#pragma unroll
    for (int nt = 0; nt < 2; ++nt)
#pragma unroll
        for (int ks = 0; ks < 2; ++ks) { const int j = 32 * cgh + 16 * nt + fr; const float* pa = L.wga + ((size_t)nblk * 64 + 32 * ks + 8 * fq) * 64 + j; const float* px = L.wgx + ((size_t)nblk * 64 + 32 * ks + 8 * fq) * 64 + j;
            unsigned a0 = cvt_pk_bf16(pa[0], pa[64]), a1 = cvt_pk_bf16(pa[128], pa[192]), a2 = cvt_pk_bf16(pa[256], pa[320]), a3 = cvt_pk_bf16(pa[384], pa[448]);
            unsigned x0 = cvt_pk_bf16(px[0], px[64]), x1 = cvt_pk_bf16(px[128], px[192]), x2 = cvt_pk_bf16(px[256], px[320]), x3 = cvt_pk_bf16(px[384], px[448]);
            v4u va = {a0, a1, a2, a3}, vx = {x0, x1, x2, x3};
            WGT[((nt * 2 + ks) * 2 + 0) * 64 + lane] = va; WGT[((nt * 2 + ks) * 2 + 1) * 64 + lane] = vx; }
    float ba[2], bx[2], sp8[2];
#pragma unroll
    for (int nt = 0; nt < 2; ++nt) { const int ch = cm0 + 16 * nt + fr; ba[nt] = L.bga[ch]; bx[nt] = L.bgx[ch]; sp8[nt] = 8.0f * log1pf(expf(-L.lam[ch])); }
    const int cgq = lane & 15;
    const f32x4 cw0 = *(const f32x4*)(L.cbw + c0 + 4 * cgq), cw1 = *(const f32x4*)(L.cbw + DM + c0 + 4 * cgq), cw2 = *(const f32x4*)(L.cbw + 2 * DM + c0 + 4 * cgq), cw3 = *(const f32x4*)(L.cbw + 3 * DM + c0 + 4 * cgq), cbias = *(const f32x4*)(L.cbb + c0 + 4 * cgq);
    float carry[2] = {0.f, 0.f};
    const int nch = (kind == 0) ? SEQ / 128 : 1;
    v4u pre0 = {0u, 0u, 0u, 0u}, pre1 = pre0, pre2 = pre0;
    int pt_[3], pc_[3], pl_[3];
#pragma unroll
    for (int i = 0; i < 3; ++i) { const int idx_ = tid + 512 * i, seg_ = idx_ / 88, rem_ = idx_ - seg_ * 88, j_ = rem_ >> 3, c8_ = rem_ & 7; pt_[i] = seg_ * 8 + j_ - 3; pc_[i] = c0 + 8 * c8_; pl_[i] = (seg_ * 11 + j_) * 64 + 8 * c8_; }
    const bool p2ok = tid < 1408 - 1024;
#define SC_PIECE(i, ckk, dstv) do { if ((i) < 2 || p2ok) { const int t_ = (ckk) * 128 + pt_[i]; \
        const v4u ld_ = *(const v4u*)(U + ((size_t)sidx * SEQ + (t_ < 0 ? 0 : t_)) * DM + pc_[i]); dstv = (t_ < 0) ? (v4u){0u, 0u, 0u, 0u} : ld_; } } while (0)
#define SC_PUT(i, srcv) do { if ((i) < 2 || p2ok) { LAS float* d_ = UE + pl_[i]; \
        *(LAS f32x4*)d_ = (f32x4){bflo(srcv.x), bfhi(srcv.x), bflo(srcv.y), bfhi(srcv.y)}; *(LAS f32x4*)(d_ + 4) = (f32x4){bflo(srcv.z), bfhi(srcv.z), bflo(srcv.w), bfhi(srcv.w)}; } } while (0)
    if (kind == 0) { SC_PIECE(0, 0, pre0); SC_PIECE(1, 0, pre1); SC_PIECE(2, 0, pre2); }
    for (int ck = 0; ck < nch; ++ck) {
        if (kind == 0) {
            SC_PUT(0, pre0); SC_PUT(1, pre1); SC_PUT(2, pre2);
            if (ck + 1 < nch) { SC_PIECE(0, ck + 1, pre0); SC_PIECE(1, ck + 1, pre1); SC_PIECE(2, ck + 1, pre2); }
        } else {
        for (int idx = tid; idx < 16 * 11 * 8; idx += 512) {
            const int seg = idx / 88, rem = idx - seg * 88, j = rem >> 3, c8 = rem & 7; float v[8];
            const int sq = sidx * 16 + seg;
            if (j < 3) { const float* p = L.scb + ((size_t)sq * 3 + j) * DM + c0 + 8 * c8; const f32x4 p0 = *(const f32x4*)p, p1 = *(const f32x4*)(p + 4);
                    v[0] = p0.x; v[1] = p0.y; v[2] = p0.z; v[3] = p0.w; v[4] = p1.x; v[5] = p1.y; v[6] = p1.z; v[7] = p1.w; }
            else { const v4u wv = *(const v4u*)(U + ((size_t)MP + sq * 8 + (j - 3)) * DM + c0 + 8 * c8); v[0] = bflo(wv.x); v[1] = bfhi(wv.x); v[2] = bflo(wv.y); v[3] = bfhi(wv.y); v[4] = bflo(wv.z); v[5] = bfhi(wv.z); v[6] = bflo(wv.w); v[7] = bfhi(wv.w); }
            LAS float* d = UE + (seg * 11 + j) * 64 + 8 * c8;
            *(LAS f32x4*)d = (f32x4){v[0], v[1], v[2], v[3]}; *(LAS f32x4*)(d + 4) = (f32x4){v[4], v[5], v[6], v[7]};
        }
        }
#if CONVA_INTERLEAVE
        ConvAReg cvr; const int cv_cur = cv_it; const bool cv_do = cv_cur < MT * 128;
        if (cv_do) { conva_load(CV, cv_cur, cvr); cv_it += cv_stride; }
#endif
        __syncthreads();
        for (int r1_ = 0; r1_ < REP_S1; ++r1_)
        { const int tk0 = 16 * w + 4 * fq, seg = tk0 >> 3, tt0 = tk0 & 7; const LAS float* p = UE + (seg * 11 + tt0) * 64 + 4 * cgq;
          f32x4 ur[7];
#pragma unroll
          for (int j = 0; j < 7; ++j) ur[j] = *(const LAS f32x4*)(p + 64 * j);
#pragma unroll
          for (int i = 0; i < 4; ++i) { const f32x4 uc = cbias + cw0 * ur[i] + cw1 * ur[i + 1] + cw2 * ur[i + 2] + cw3 * ur[i + 3];
              v2u pk; pk.x = cvt_pk_bf16(uc.x, uc.y); pk.y = cvt_pk_bf16(uc.z, uc.w); *(LAS v2u*)(UCB + (tk0 + i) * 72 + 4 * cgq) = pk;
              if ((cgq >> 3) == cgh) *(LAS f32x4*)(UCF + (tk0 + i) * 36 + 4 * (cgq & 7)) = uc; } }
        if (kind == 1 || ck == nch - 1)
        for (int idx = tid; idx < 16 * 3 * 32; idx += 512) { const int seg = idx / 96, jj = (idx >> 5) % 3, c = idx & 31; const float val = UE[(seg * 11 + 8 + jj) * 64 + 32 * cgh + c];
            if (kind == 1) sb[((size_t)(sidx * 16 + seg) * 3 + jj) * DM + cm0 + c] = val;
            else if (ck == nch - 1 && seg == 15) pcb[((size_t)sidx * 3 + jj) * DM + cm0 + c] = val; }
        LDS_WAIT(); asm volatile("" ::: "memory");
        f32x4 ra[2], rx[2];
        { bf16x8 af[2];
#pragma unroll
          for (int ks = 0; ks < 2; ++ks) af[ks] = *(const LAS bf16x8*)(UCB + (16 * w + fr) * 72 + 32 * ks + 8 * fq);
#pragma unroll
          for (int nt = 0; nt < 2; ++nt) { ra[nt] = (f32x4){0.f, 0.f, 0.f, 0.f}; rx[nt] = (f32x4){0.f, 0.f, 0.f, 0.f};
#pragma unroll
              for (int ks = 0; ks < 2; ++ks) { const bf16x8 wa_ = __builtin_bit_cast(bf16x8, WGT[((nt * 2 + ks) * 2 + 0) * 64 + lane]), wx_ = __builtin_bit_cast(bf16x8, WGT[((nt * 2 + ks) * 2 + 1) * 64 + lane]);
                  ra[nt] = __builtin_amdgcn_mfma_f32_16x16x32_bf16(af[ks], wa_, ra[nt], 0, 0, 0); rx[nt] = __builtin_amdgcn_mfma_f32_16x16x32_bf16(af[ks], wx_, rx[nt], 0, 0, 0); } } }
        float Ap[2][4], Bp[2][4], eA[2], eB[2], At[2], Bt[2];
#pragma unroll
        for (int nt = 0; nt < 2; ++nt) {
#pragma unroll
            for (int rg = 0; rg < 4; ++rg) { const int tk = 16 * w + 4 * fq + rg, c = 16 * nt + fr; const float uc = UCF[tk * 36 + c];
                const float r = fsig(ra[nt][rg] + ba[nt]), ii = fsig(rx[nt][rg] + bx[nt]); const float la = -sp8[nt] * r;
                const float av = __expf(la), bv = __builtin_amdgcn_sqrtf(fmaxf(1.0f - av * av, 0.f)) * ii * uc;
                if (rg == 0) { Ap[nt][0] = av; Bp[nt][0] = bv; } else { Ap[nt][rg] = av * Ap[nt][rg - 1]; Bp[nt][rg] = av * Bp[nt][rg - 1] + bv; } }
            float A_ = Ap[nt][3], B_ = Bp[nt][3];
            { const float pA = __shfl_up(A_, 16), pB = __shfl_up(B_, 16); const bool c1 = (kind == 0) ? (fq >= 1) : ((fq & 1) != 0); if (c1) { B_ = A_ * pB + B_; A_ = pA * A_; } }
            if (kind == 0) { const float pA = __shfl_up(A_, 32), pB = __shfl_up(B_, 32); if (fq >= 2) { B_ = A_ * pB + B_; A_ = pA * A_; } }
            { float xA = __shfl_up(A_, 16), xB = __shfl_up(B_, 16); const bool first = (kind == 0) ? (fq == 0) : ((fq & 1) == 0); if (first) { xA = 1.f; xB = 0.f; } eA[nt] = xA; eB[nt] = xB; }
            At[nt] = A_; Bt[nt] = B_;
        }
        float hst[2];
        if (kind == 0) {
            typedef float f32x2s __attribute__((ext_vector_type(2)));
            LAS f32x2s* SW = (LAS f32x2s*)(lds + SC_SEGA) + (ck & 1) * 256;
            if (fq == 3) { SW[w * 32 + fr] = (f32x2s){At[0], Bt[0]}; SW[w * 32 + 16 + fr] = (f32x2s){At[1], Bt[1]}; }
            __syncthreads();
#pragma unroll
            for (int nt = 0; nt < 2; ++nt) { float h = carry[nt], hin = 0.f;
#pragma unroll
                for (int ww = 0; ww < 8; ++ww) { const f32x2s ab = SW[ww * 32 + 16 * nt + fr]; if (ww == w) hin = h; h = ab.x * h + ab.y; }
                carry[nt] = h; hst[nt] = eA[nt] * hin + eB[nt]; }
        } else {
#pragma unroll
            for (int nt = 0; nt < 2; ++nt) { const float hin = L.sh[(size_t)(sidx * 16 + 2 * w + (fq >> 1)) * DM + cm0 + 16 * nt + fr]; hst[nt] = eA[nt] * hin + eB[nt]; }
        }
#pragma unroll
        for (int nt = 0; nt < 2; ++nt) {
#pragma unroll
            for (int rg = 0; rg < 4; ++rg) { const float h = Ap[nt][rg] * hst[nt] + Bp[nt][rg]; HOUT[(16 * w + 4 * fq + rg) * 32 + 16 * nt + fr] = (bf16)(cvt_pk_bf16(h, 0.f) & 0xffffu);
                if (rg == 3 && kind == 1 && (fq & 1)) sh[(size_t)(sidx * 16 + 2 * w + (fq >> 1)) * DM + cm0 + 16 * nt + fr] = h; }
            if (kind == 0 && ck == nch - 1 && w == 0 && fq == 0) ph[(size_t)sidx * DM + cm0 + 16 * nt + fr] = carry[nt];
        }
        LDS_WAIT(); asm volatile("" ::: "memory");
        for (int r3_ = 0; r3_ < REP_S3; ++r3_)
        { const int row = tid >> 2, part = tid & 3; const v4u v = *(const LAS v4u*)(HOUT + row * 32 + part * 8);
          const size_t grow = (kind == 0) ? (size_t)sidx * SEQ + ck * 128 + row : (size_t)MP + (size_t)sidx * 128 + row;
          *(v4u*)(HS + grow * DM + cm0 + part * 8) = v; }
#if CONVA_INTERLEAVE
        if (cv_do) conva_finish(CV, L, cv_cur, cvr);
#endif
    }
    __syncthreads();
#undef SC_PIECE
#undef SC_PUT
}

constexpr int KSTP = 272;
constexpr int KSTR = 264;
constexpr float SM_C = 0.0625f * 1.4426950408889634f;
__device__ __forceinline__ void attn_prompt_unit(LAS unsigned char* lds, const bf16* Q, const bf16* KB, const bf16* VT, bf16* O, int b, int h, int qt) {
    int tid_ = threadIdx.x; asm volatile("" : "+v"(tid_));
    const int tid = tid_, lane = tid & 63, w = tid >> 6, fr = lane & 15, fq = lane >> 4;
    LAS bf16* TL = (LAS bf16*)lds; LAS bf16* PW = (LAS bf16*)(lds + 64 * KSTP * 2 + w * (16 * KSTP * 2));
    const size_t qrow0 = (size_t)b * SEQ + qt * 128 + 16 * w;
    const int pm_ = tid >> 5, pc_ = (tid & 31) * 8;
    const bf16* ksrc = KB + ((size_t)b * NMEM + pm_) * DM + h * HD + pc_;
    const bf16* vsrc = VT + ((size_t)(b * NH + h) * HD + pm_) * NMEM + pc_;
    v4u nx0, nx1, nx2, nx3;
#define AT_LOADK(jt) do { const bf16* p_ = ksrc + (size_t)(64 * (jt)) * DM; nx0 = *(const v4u*)p_; nx1 = *(const v4u*)(p_ + 16 * DM); nx2 = *(const v4u*)(p_ + 32 * DM); nx3 = *(const v4u*)(p_ + 48 * DM); } while (0)
#define AT_LOADV(jt) do { const bf16* p_ = vsrc + (size_t)(64 * (jt)) * NMEM; nx0 = *(const v4u*)p_; nx1 = *(const v4u*)(p_ + 16 * NMEM); nx2 = *(const v4u*)(p_ + 32 * NMEM); nx3 = *(const v4u*)(p_ + 48 * NMEM); } while (0)
#define AT_PUT() do { LAS bf16* d_ = TL + pm_ * KSTP + pc_; *(LAS v4u*)d_ = nx0; *(LAS v4u*)(d_ + 16 * KSTP) = nx1; *(LAS v4u*)(d_ + 32 * KSTP) = nx2; *(LAS v4u*)(d_ + 48 * KSTP) = nx3; } while (0)
    AT_LOADK(0);
    bf16x8 qf[8];
#pragma unroll
    for (int ks = 0; ks < 8; ++ks) qf[ks] = *(const bf16x8*)(Q + (qrow0 + fr) * DM + h * HD + 32 * ks + 8 * fq);
    f32x4 s[16];
#pragma unroll
    for (int i = 0; i < 16; ++i) s[i] = (f32x4){0.f, 0.f, 0.f, 0.f};
#pragma unroll
    for (int jt = 0; jt < 4; ++jt) {
        AT_PUT();
        __syncthreads();
        if (jt < 3) AT_LOADK(jt + 1); else AT_LOADV(0);
        { bf16x8 fb[2][8];
#pragma unroll
          for (int ks = 0; ks < 8; ++ks) fb[0][ks] = *(const LAS bf16x8*)(TL + fr * KSTP + 32 * ks + 8 * fq);
#pragma unroll
          for (int nt = 0; nt < 4; ++nt) {
              if (nt < 3) {
#pragma unroll
                  for (int ks = 0; ks < 8; ++ks) fb[(nt + 1) & 1][ks] = *(const LAS bf16x8*)(TL + (16 * (nt + 1) + fr) * KSTP + 32 * ks + 8 * fq); }
              __builtin_amdgcn_sched_barrier(0); __builtin_amdgcn_s_setprio(1);
#pragma unroll
              for (int ks = 0; ks < 8; ++ks) s[4 * jt + nt] = __builtin_amdgcn_mfma_f32_16x16x32_bf16(fb[nt & 1][ks], qf[ks], s[4 * jt + nt], 0, 0, 0);
              __builtin_amdgcn_s_setprio(0); __builtin_amdgcn_sched_barrier(0);
          } }
        __syncthreads();
    }
    { float mx = s[0][0];
#pragma unroll
      for (int nt = 0; nt < 16; ++nt) mx = fmaxf(fmaxf(mx, fmaxf(s[nt][0], s[nt][1])), fmaxf(s[nt][2], s[nt][3]));
      mx = fmaxf(mx, __shfl_xor(mx, 16)); mx = fmaxf(mx, __shfl_xor(mx, 32));
      float sum = 0.f;
#pragma unroll
      for (int nt = 0; nt < 16; ++nt)
#pragma unroll
          for (int rg = 0; rg < 4; ++rg) { const float p = exp2f((s[nt][rg] - mx) * SM_C); s[nt][rg] = p; sum += p; }
      sum += __shfl_xor(sum, 16); sum += __shfl_xor(sum, 32);
      const float inv = 1.0f / sum;
#pragma unroll
      for (int nt = 0; nt < 16; ++nt) { v2u pk; pk.x = cvt_pk_bf16(s[nt][0] * inv, s[nt][1] * inv); pk.y = cvt_pk_bf16(s[nt][2] * inv, s[nt][3] * inv); *(LAS v2u*)(PW + fr * KSTP + 16 * nt + 4 * fq) = pk; } }
    LDS_WAIT(); asm volatile("" ::: "memory");
    bf16x8 pf[8];
#pragma unroll
    for (int ks = 0; ks < 8; ++ks) pf[ks] = *(const LAS bf16x8*)(PW + fr * KSTP + 32 * ks + 8 * fq);
#pragma unroll
    for (int jt = 0; jt < 4; ++jt) {
        AT_PUT();
        __syncthreads();
        if (jt < 3) AT_LOADV(jt + 1);
        { bf16x8 fb[2][8];
#pragma unroll
          for (int ks = 0; ks < 8; ++ks) fb[0][ks] = *(const LAS bf16x8*)(TL + fr * KSTP + 32 * ks + 8 * fq);
#pragma unroll
          for (int nt = 0; nt < 4; ++nt) { f32x4 o = (f32x4){0.f, 0.f, 0.f, 0.f};
              if (nt < 3) {
#pragma unroll
                  for (int ks = 0; ks < 8; ++ks) fb[(nt + 1) & 1][ks] = *(const LAS bf16x8*)(TL + (16 * (nt + 1) + fr) * KSTP + 32 * ks + 8 * fq); }
              __builtin_amdgcn_sched_barrier(0); __builtin_amdgcn_s_setprio(1);
#pragma unroll
              for (int ks = 0; ks < 8; ++ks) o = __builtin_amdgcn_mfma_f32_16x16x32_bf16(fb[nt & 1][ks], pf[ks], o, 0, 0, 0);
              __builtin_amdgcn_s_setprio(0); __builtin_amdgcn_sched_barrier(0);
              v2u pk; pk.x = cvt_pk_bf16(o[0], o[1]); pk.y = cvt_pk_bf16(o[2], o[3]);
              *(v2u*)(O + (qrow0 + fr) * DM + h * HD + 64 * jt + 16 * nt + 4 * fq) = pk; } }
        __syncthreads();
    }
#undef AT_LOADK
#undef AT_LOADV
#undef AT_PUT
}
__device__ __forceinline__ void attn_sample_units(LAS unsigned char* lds, const bf16* Q, const float* CK, const float* CV, bf16* O, int first, int stride) {
    int tid_ = threadIdx.x; asm volatile("" : "+v"(tid_));
    const int tid = tid_, lane = tid & 63, w = tid >> 6, fr = lane & 15, fq = lane >> 4;
    LAS bf16* KS = (LAS bf16*)lds; LAS bf16* PS = (LAS bf16*)(lds + 135168); LAS float* RED = (LAS float*)(lds + 143616);
    constexpr int KPF = 8;
    f32x4 kp[KPF];
#define AS_KBASE(u_) (CK + ((size_t)((u_) >> 2) * NMEM * NH + ((u_) & 3)) * HD)
#define AS_KLOAD(u_) do { const float* kb_ = AS_KBASE(u_); _Pragma("unroll") for (int i = 0; i < KPF; ++i) { const int idx = i * 512 + tid, m = idx >> 6, d4 = idx & 63; kp[i] = __builtin_nontemporal_load((const f32x4*)(kb_ + (size_t)m * DM + 4 * d4)); } } while (0)
    int u = first;
    if (u < 512) AS_KLOAD(u);
    for (; u < 512; u += stride) {
        const int b = u >> 2, h = u & 3;
        const float* kbase = AS_KBASE(u);
        const float* vbase = CV + ((size_t)b * NMEM * NH + h) * HD;
#pragma unroll
        for (int i = 0; i < KPF; ++i) { const int idx = i * 512 + tid, m = idx >> 6, d4 = idx & 63; v2u o; o.x = cvt_pk_bf16(kp[i].x, kp[i].y); o.y = cvt_pk_bf16(kp[i].z, kp[i].w); *(LAS v2u*)(KS + m * KSTR + 4 * d4) = o; }
#pragma unroll 8
        for (int i = KPF; i < 32; ++i) { const int idx = i * 512 + tid, m = idx >> 6, d4 = idx & 63; const f32x4 v = __builtin_nontemporal_load((const f32x4*)(kbase + (size_t)m * DM + 4 * d4));
            v2u o; o.x = cvt_pk_bf16(v.x, v.y); o.y = cvt_pk_bf16(v.z, v.w); *(LAS v2u*)(KS + m * KSTR + 4 * d4) = o; }
        bf16x8 qf[8];
#pragma unroll
        for (int ks = 0; ks < 8; ++ks) { if (fr < 8) qf[ks] = *(const bf16x8*)(Q + ((size_t)MP + b * DSEQ + fr) * DM + h * HD + 32 * ks + 8 * fq); else qf[ks] = (bf16x8){0, 0, 0, 0, 0, 0, 0, 0}; }
        __syncthreads();
        f32x4 vp[16];
#pragma unroll
        for (int i = 0; i < 8; ++i) { const int mp = i * 8 + (lane & 7), d4 = w * 8 + (lane >> 3);
            vp[2 * i] = __builtin_nontemporal_load((const f32x4*)(vbase + (size_t)(2 * mp) * DM + 4 * d4)); vp[2 * i + 1] = __builtin_nontemporal_load((const f32x4*)(vbase + (size_t)(2 * mp + 1) * DM + 4 * d4)); }
        f32x4 s[2];
#pragma unroll
        for (int nt = 0; nt < 2; ++nt) { s[nt] = (f32x4){0.f, 0.f, 0.f, 0.f};
#pragma unroll
            for (int ks = 0; ks < 8; ++ks) { const bf16x8 bfr = *(const LAS bf16x8*)(KS + (32 * w + 16 * nt + fr) * KSTR + 32 * ks + 8 * fq); s[nt] = __builtin_amdgcn_mfma_f32_16x16x32_bf16(bfr, qf[ks], s[nt], 0, 0, 0); } }
        { float m_ = fmaxf(fmaxf(fmaxf(s[0][0], s[0][1]), fmaxf(s[0][2], s[0][3])), fmaxf(fmaxf(s[1][0], s[1][1]), fmaxf(s[1][2], s[1][3])));
          m_ = fmaxf(m_, __shfl_xor(m_, 16)); m_ = fmaxf(m_, __shfl_xor(m_, 32));
          if (fq == 0) RED[w * 16 + fr] = m_; }
        __syncthreads();
        { float m_ = RED[fr];
#pragma unroll
          for (int ww = 1; ww < 8; ++ww) m_ = fmaxf(m_, RED[ww * 16 + fr]);
          float sum = 0.f;
#pragma unroll
          for (int nt = 0; nt < 2; ++nt)
#pragma unroll
              for (int rg = 0; rg < 4; ++rg) { const float p = exp2f((s[nt][rg] - m_) * SM_C); s[nt][rg] = p; sum += p; }
          sum += __shfl_xor(sum, 16); sum += __shfl_xor(sum, 32);
          if (fq == 0) RED[128 + w * 16 + fr] = sum; }
#pragma unroll
        for (int i = 0; i < 8; ++i) { const int mp = i * 8 + (lane & 7), d4 = w * 8 + (lane >> 3); const f32x4 v0 = vp[2 * i], v1 = vp[2 * i + 1];
            LAS unsigned* dst = (LAS unsigned*)(KS + (4 * d4) * KSTR + 2 * mp);
            dst[0] = cvt_pk_bf16(v0.x, v1.x); dst[KSTR / 2] = cvt_pk_bf16(v0.y, v1.y); dst[KSTR] = cvt_pk_bf16(v0.z, v1.z); dst[3 * KSTR / 2] = cvt_pk_bf16(v0.w, v1.w); }
#pragma unroll 4
        for (int i = 8; i < 16; ++i) { const int mp = i * 8 + (lane & 7), d4 = w * 8 + (lane >> 3);
            const f32x4 v0 = __builtin_nontemporal_load((const f32x4*)(vbase + (size_t)(2 * mp) * DM + 4 * d4)), v1 = __builtin_nontemporal_load((const f32x4*)(vbase + (size_t)(2 * mp + 1) * DM + 4 * d4));
            LAS unsigned* dst = (LAS unsigned*)(KS + (4 * d4) * KSTR + 2 * mp);
            dst[0] = cvt_pk_bf16(v0.x, v1.x); dst[KSTR / 2] = cvt_pk_bf16(v0.y, v1.y); dst[KSTR] = cvt_pk_bf16(v0.z, v1.z); dst[3 * KSTR / 2] = cvt_pk_bf16(v0.w, v1.w); }
        __syncthreads();
        { float tot = RED[128 + fr];
#pragma unroll
          for (int ww = 1; ww < 8; ++ww) tot += RED[128 + ww * 16 + fr];
          const float inv = 1.0f / tot;
#pragma unroll
          for (int nt = 0; nt < 2; ++nt) { v2u pk; pk.x = cvt_pk_bf16(s[nt][0] * inv, s[nt][1] * inv); pk.y = cvt_pk_bf16(s[nt][2] * inv, s[nt][3] * inv); *(LAS v2u*)(PS + fr * KSTR + 32 * w + 16 * nt + 4 * fq) = pk; } }
        __syncthreads();
        if (u + stride < 512) AS_KLOAD(u + stride);
#pragma unroll
        for (int nt = 0; nt < 2; ++nt) { f32x4 o = (f32x4){0.f, 0.f, 0.f, 0.f};
#pragma unroll
            for (int ks = 0; ks < 8; ++ks) { const bf16x8 pfr = *(const LAS bf16x8*)(PS + fr * KSTR + 32 * ks + 8 * fq); const bf16x8 bfr = *(const LAS bf16x8*)(KS + (32 * w + 16 * nt + fr) * KSTR + 32 * ks + 8 * fq);
                o = __builtin_amdgcn_mfma_f32_16x16x32_bf16(bfr, pfr, o, 0, 0, 0); }
            if (fr < 8) { v2u pk; pk.x = cvt_pk_bf16(o[0], o[1]); pk.y = cvt_pk_bf16(o[2], o[3]); *(v2u*)(O + ((size_t)MP + b * DSEQ + fr) * DM + h * HD + 32 * w + 16 * nt + 4 * fq) = pk; } }
        __syncthreads();
    }
#undef AS_KBASE
#undef AS_KLOAD
}
template <int KS, class Epi> __device__ __forceinline__ void mini_gemm(LAS unsigned char* lds, const bf16* A, const bf16* Bt, int K, int N, int row_base, int nrows, const Epi& E, int first, int stride) {
    int tid_ = threadIdx.x; asm volatile("" : "+v"(tid_));
    const int lane = tid_ & 63, w = tid_ >> 6, fr = lane & 15, fq = lane >> 4;
    const int ntn = N / 64, ntiles = (nrows / 64) * ntn;
    LAS f32x4* RED = (LAS f32x4*)lds;
    for (int t = first; t < ntiles; t += stride) {
        const int tm = t / ntn, tn = t - tm * ntn;
        const int r0 = row_base + tm * 64, c0 = tn * 64;
        const bf16* ap = A + (size_t)(r0 + fr) * K + 8 * fq + 32 * w * KS;
        const bf16* bp = Bt + (size_t)(c0 + fr) * K + 8 * fq + 32 * w * KS;
        f32x4 acc[4][4];
#pragma unroll
        for (int i = 0; i < 4; ++i)
#pragma unroll
            for (int j = 0; j < 4; ++j) acc[i][j] = (f32x4){0.f, 0.f, 0.f, 0.f};
#pragma unroll
        for (int k0 = 0; k0 < KS; k0 += 4) { bf16x8 a[4][4], b[4][4];
#pragma unroll
            for (int kk = 0; kk < 4; ++kk) if (k0 + kk < KS) {
#pragma unroll
                for (int i = 0; i < 4; ++i) { a[kk][i] = *(const bf16x8*)(ap + (size_t)(16 * i) * K + 32 * (k0 + kk)); b[kk][i] = *(const bf16x8*)(bp + (size_t)(16 * i) * K + 32 * (k0 + kk)); } }
            __builtin_amdgcn_sched_barrier(0);
#pragma unroll
            for (int kk = 0; kk < 4; ++kk) if (k0 + kk < KS) {
#pragma unroll
                for (int i = 0; i < 4; ++i)
#pragma unroll
                    for (int j = 0; j < 4; ++j) acc[i][j] = __builtin_amdgcn_mfma_f32_16x16x32_bf16(b[kk][j], a[kk][i], acc[i][j], 0, 0, 0); }
            __builtin_amdgcn_sched_barrier(0);
        }
#pragma unroll
        for (int i = 0; i < 4; ++i)
#pragma unroll
            for (int j = 0; j < 4; ++j) RED[(w * 16 + i * 4 + j) * 64 + lane] = acc[i][j];
        __syncthreads();
#pragma unroll
        for (int q = 0; q < 2; ++q) { const int st = 2 * w + q, mt = st >> 2, nt = st & 3; f32x4 v = RED[st * 64 + lane];
#pragma unroll
            for (int ww = 1; ww < 8; ++ww) v = v + RED[(ww * 16 + st) * 64 + lane];
            E.apply(r0 + 16 * mt + fr, c0 + 16 * nt + 4 * fq, v); }
        __syncthreads();
    }
}

__device__ __forceinline__ void mini_gemm_dual(LAS unsigned char* lds, const bf16* A1, const bf16* B1, const bf16* A2, const bf16* B2, const bf16* m1, const bf16* m2, bf16* Zo, int row_base, int nrows, int first, int stride) {
    int tid_ = threadIdx.x; asm volatile("" : "+v"(tid_));
    const int lane = tid_ & 63, w = tid_ >> 6, fr = lane & 15, fq = lane >> 4;
    constexpr int K = DM, KS = 4; const int ntn = DM / 64, ntiles = (nrows / 64) * ntn;
    LAS f32x4* RED = (LAS f32x4*)lds;
    for (int t = first; t < ntiles; t += stride) {
        const int tm = t / ntn, tn = t - tm * ntn;
        const int r0 = row_base + tm * 64, c0 = tn * 64;
        f32x4 zkeep[2];
#pragma unroll
        for (int pass = 0; pass < 2; ++pass) {
            const bf16* ap = (pass ? A2 : A1) + (size_t)(r0 + fr) * K + 8 * fq + 32 * w * KS;
            const bf16* bp = (pass ? B2 : B1) + (size_t)(c0 + fr) * K + 8 * fq + 32 * w * KS;
            f32x4 acc[4][4];
#pragma unroll
            for (int i = 0; i < 4; ++i)
#pragma unroll
                for (int j = 0; j < 4; ++j) acc[i][j] = (f32x4){0.f, 0.f, 0.f, 0.f};
            bf16x8 a[4][4], b[4][4];
#pragma unroll
            for (int kk = 0; kk < 4; ++kk)
#pragma unroll
                for (int i = 0; i < 4; ++i) { a[kk][i] = *(const bf16x8*)(ap + (size_t)(16 * i) * K + 32 * kk); b[kk][i] = *(const bf16x8*)(bp + (size_t)(16 * i) * K + 32 * kk); }
            __builtin_amdgcn_sched_barrier(0);
#pragma unroll
            for (int kk = 0; kk < 4; ++kk)
#pragma unroll
                for (int i = 0; i < 4; ++i)
#pragma unroll
                    for (int j = 0; j < 4; ++j) acc[i][j] = __builtin_amdgcn_mfma_f32_16x16x32_bf16(b[kk][j], a[kk][i], acc[i][j], 0, 0, 0);
            __builtin_amdgcn_sched_barrier(0);
#pragma unroll
            for (int i = 0; i < 4; ++i)
#pragma unroll
                for (int j = 0; j < 4; ++j) RED[(w * 16 + i * 4 + j) * 64 + lane] = acc[i][j];
            __syncthreads();
#pragma unroll
            for (int q = 0; q < 2; ++q) { const int st = 2 * w + q, mt = st >> 2, nt = st & 3; f32x4 v = RED[st * 64 + lane];
#pragma unroll
                for (int ww = 1; ww < 8; ++ww) v = v + RED[(ww * 16 + st) * 64 + lane];
                const size_t o = (size_t)(r0 + 16 * mt + fr) * DM + c0 + 16 * nt + 4 * fq;
                if (pass == 0) { zkeep[q] = v * pg8::ld_bf16x4(m1 + o); }
                else { pg8::st_bf16x4(Zo + o, zkeep[q] + v * pg8::ld_bf16x4(m2 + o)); } }
            __syncthreads();
        }
    }
}

struct Args { const float* in[26]; float* out; unsigned char* ws; };
typedef __attribute__((address_space(4))) const unsigned char* karg_t;
__device__ __forceinline__ const float* karg_in(int i) { karg_t p = (karg_t)__builtin_amdgcn_kernarg_segment_ptr(); asm volatile("" : "+s"(p)); return *(const float* __attribute__((address_space(4))) const*)(p + 8 * i); }
__device__ __forceinline__ float* karg_out() { karg_t p = (karg_t)__builtin_amdgcn_kernarg_segment_ptr(); asm volatile("" : "+s"(p)); return *(float* __attribute__((address_space(4))) const*)(p + 8 * 26); }
__device__ __forceinline__ unsigned char* karg_ws() { karg_t p = (karg_t)__builtin_amdgcn_kernarg_segment_ptr(); asm volatile("" : "+s"(p)); return *(unsigned char* __attribute__((address_space(4))) const*)(p + 8 * 27); }
#define ARGIN(i) karg_in(i)
__device__ __forceinline__ int opaque_i(int v) { asm volatile("" : "+s"(v)); return v; }
__device__ __forceinline__ int vcu_of(int g, int b) { return (g % 8 == 0) ? (b % 8) * (g / 8) + b / 8 : b; }
__global__ void __launch_bounds__(NWAVES * 64, 2) fwd_megakernel(Args args_unused) {
    extern __shared__ __attribute__((aligned(16))) unsigned char lds_raw[];
    LAS unsigned char* lds = (LAS unsigned char*)lds_raw;
#define tid ((int)threadIdx.x)
#define lane (tid & 63)
#define wave (__builtin_amdgcn_readfirstlane(tid >> 6))
#define G (opaque_i((int)gridDim.x))
#define bx ((int)blockIdx.x)
#define vcu (vcu_of(G, bx))
    for (int u = tid; u < 256; u += NWAVES * 64) ((LAS unsigned*)(lds + MISC_OFF))[u] = 0u;
    __syncthreads();
    XcdBarrier bar = xcd_barrier_post((unsigned*)(karg_ws() + WS_CTL) + CW_BAR, (volatile LAS unsigned*)(lds + MISC_OFF) + 8);
#define GRID_BAR() do { for (int rb_ = 0; rb_ < REP_BAR; ++rb_) xcd_barrier(bar); } while (0)
#define gw (vcu * NWAVES + wave)
#define NGW (G * NWAVES)
#define ws (karg_ws())
#define out (karg_out())
#define XN ((bf16*)(ws + WS_XN))
#define MN ((bf16*)(ws + WS_MN))
#define PROJ ((bf16*)(ws + WS_PROJ))
#define CA ((bf16*)(ws + WS_CA))
#define HS ((bf16*)(ws + WS_HS))
#define YC ((bf16*)(ws + WS_YC))
#define Z ((bf16*)(ws + WS_Z))
#define T ((bf16*)(ws + WS_T))
#define X ((bf16*)(ws + WS_X))
#define Qb ((bf16*)(ws + WS_Q))
#define Ob ((bf16*)(ws + WS_O))
#define ACT ((bf16*)(ws + WS_ACT))
#define MKB ((bf16*)(ws + WS_MKB))
#define MVT ((bf16*)(ws + WS_MVT))
#define gains (ARGIN(8))
#if (PHM >> 0) & 1
    for (int rp_ = 0; rp_ < REP_PRO; ++rp_) {
        LAS float* scr = (LAS float*)(lds + wave * 16384);
        constexpr int NIT = 10880;
        for (int it = gw; it < 2 * NIT; it += NGW) {
            const int l = it / NIT; int r = it - l * NIT; bf16* wb = (bf16*)(ws + WS_W + (size_t)l * W_LAYER);
            if (r < 3072) { transpose_item(ARGIN(9) + (size_t)l * DM * DIN, DM, DIN, (bf16*)((unsigned char*)wb + WO_IN), 1, scr, r, lane); continue; } r -= 3072;
            if (r < 512) { transpose_item(ARGIN(11) + (size_t)l * DM * DM, DM, DM, (bf16*)((unsigned char*)wb + WO_CO), 0, scr, r, lane); continue; } r -= 512;
            if (r < 512) { transpose_item(ARGIN(19) + (size_t)l * DM * DM, DM, DM, (bf16*)((unsigned char*)wb + WO_RO), 0, scr, r, lane); continue; } r -= 512;
            if (r < 512) { transpose_item(ARGIN(20) + (size_t)l * DM * DM, DM, DM, (bf16*)((unsigned char*)wb + WO_MIX), 0, scr, r, lane); continue; } r -= 512;
            if (r < 1024) { transpose_item(ARGIN(21) + (size_t)l * DM * 2 * DM, DM, 2 * DM, (bf16*)((unsigned char*)wb + WO_KV), 0, scr, r, lane); continue; } r -= 1024;
            if (r < 512) { transpose_item(ARGIN(22) + (size_t)l * DM * DM, DM, DM, (bf16*)((unsigned char*)wb + WO_Q), 0, scr, r, lane); continue; } r -= 512;
            if (r < 512) { transpose_item(ARGIN(23) + (size_t)l * DM * DM, DM, DM, (bf16*)((unsigned char*)wb + WO_O), 0, scr, r, lane); continue; } r -= 512;
            if (r < 2816) { transpose_item(ARGIN(24) + (size_t)l * DM * 2 * DFF, DM, 2 * DFF, (bf16*)((unsigned char*)wb + WO_FI), 2, scr, r, lane); continue; } r -= 2816;
            transpose_item(ARGIN(25) + (size_t)l * DFF * DM, DFF, DM, (bf16*)((unsigned char*)wb + WO_FO), 0, scr, r, lane);
        }
        for (int m = gw; m < MT; m += NGW) rms_row_to_bf16((m < MP) ? ARGIN(0) + (size_t)m * DM : ARGIN(1) + (size_t)(m - MP) * DM, gains, XN + (size_t)m * DM, lane);
        for (int m = gw; m < 2 * MROWS; m += NGW) { const int l = m / MROWS, rr = m - l * MROWS; rms_row_to_bf16(ARGIN(7) + (size_t)rr * DM, gains + ((size_t)l * 7 + 6) * DM, MN + (size_t)m * DM, lane); }
    }
    GRID_BAR();

#endif
#if (PHM >> 1) & 1
    for (int l = 0; l < DEPTH; ++l) {
        const bf16* wkv = (const bf16*)(ws + WS_W + (size_t)l * W_LAYER + WO_KV);
        pg8::Gemm g{MN + (size_t)l * MROWS * DM, wkv, MROWS, 2 * DM, DM}; pg8::StaticOrder S; const int cmk = bx - 96 - 64 * l;
        S.init(MROWS, 2 * DM, G, (G == 256) ? ((cmk >= 0 && cmk < 64) ? cmk : (1 << 20)) : bx);
        pg8::EpiMemKV E{out + OFF_PK + (size_t)l * MROWS * DM, out + OFF_PV + (size_t)l * MROWS * DM, MKB + (size_t)l * MROWS * DM, MVT + (size_t)l * MROWS * DM};
        pg8::gemm_phase<pg8::EpiMemKV, pg8::StaticOrder, true, true>(lds, g, S, E);
    }
#endif

    for (int l = 0; l < DEPTH; ++l) {
#define wl ((const unsigned char*)(ws + WS_W + (size_t)l * W_LAYER))
#define gl (gains + (size_t)l * 7 * DM)
#define MAKE_L() LayerIn L; L.sca = ARGIN(2) + (size_t)l * DB * 2 * DM; L.scb = ARGIN(3) + (size_t)l * DB * 3 * DM; L.sh = ARGIN(4) + (size_t)l * DB * DM; \
        L.caw = ARGIN(10) + (size_t)l * 3 * DM; L.cbw = ARGIN(12) + (size_t)l * 4 * DM; L.cbb = ARGIN(13) + (size_t)l * DM; \
        L.wga = ARGIN(14) + (size_t)l * 16 * 64 * 64; L.bga = ARGIN(15) + (size_t)l * DM; L.wgx = ARGIN(16) + (size_t)l * 16 * 64 * 64; L.bgx = ARGIN(17) + (size_t)l * DM; L.lam = ARGIN(18) + (size_t)l * DM
#if (PHM >> 2) & 1
        { pg8::Gemm g{XN, (const bf16*)(wl + WO_IN), MT, DIN, DM}; pg8::StaticOrder S; S.init(MT, DIN, G, bx); pg8::EpiInProj E{PROJ, SLOT};
          pg8::gemm_phase<pg8::EpiInProj, pg8::StaticOrder, true, true>(lds, g, S, E); }
        GRID_BAR();
#endif
#if (PHM >> 3) & 1
        for (int rs_ = 0; rs_ < REP_SCAN; ++rs_) { MAKE_L();
          ConvA CV{PROJ, PROJ + SLOT, CA, out + OFF_PCA + (size_t)l * 8 * 2 * DM, out + OFF_SA + (size_t)l * DB * 2 * DM};
          int cv_it = vcu * 512 + tid; asm volatile("" : "+v"(cv_it)); const int cv_stride = G * 512;
          for (int u = vcu; u < 512; u += G) { const int kind = u >> 8, uu = u & 255;
              scan_unit(lds, PROJ + 2 * SLOT, HS, L, out + OFF_PCB + (size_t)l * 8 * 3 * DM, out + OFF_PH + (size_t)l * 8 * DM, out + OFF_SB + (size_t)l * DB * 3 * DM, out + OFF_SH + (size_t)l * DB * DM, kind, uu >> 5, uu & 31, CV, cv_it, cv_stride); }
          for (; cv_it < MT * 128; cv_it += cv_stride) conva_item(CV, L, cv_it); }
        GRID_BAR();
#endif
#if (PHM >> 4) & 1
        { pg8::Gemm g{CA, (const bf16*)(wl + WO_CO), MP, DM, DM}; pg8::StaticOrder S; S.init(MP, DM, G, bx); pg8::EpiBf<1> E{YC, PROJ + 3 * SLOT, nullptr, DM};
          pg8::gemm_phase<pg8::EpiBf<1>, pg8::StaticOrder, true, true>(lds, g, S, E);
          }
        asm volatile("s_waitcnt vmcnt(0)" ::: "memory"); __syncthreads();
#endif
#if (PHM >> 5) & 1
        { pg8::Gemm g{HS, (const bf16*)(wl + WO_RO), MP, DM, DM}; pg8::StaticOrder S; S.init(MP, DM, G, bx); pg8::EpiBf<2> E{Z, PROJ + 4 * SLOT, YC, DM};
          pg8::gemm_phase<pg8::EpiBf<2>, pg8::StaticOrder, true, true>(lds, g, S, E);
          mini_gemm_dual(lds, CA, (const bf16*)(wl + WO_CO), HS, (const bf16*)(wl + WO_RO), PROJ + 3 * SLOT, PROJ + 4 * SLOT, Z, MP, MS, vcu, G); }
        GRID_BAR();
#endif
#if (PHM >> 6) & 1
        { pg8::Gemm g{Z, (const bf16*)(wl + WO_MIX), MP, DM, DM}; pg8::StaticOrder S; S.init(MP, DM, G, bx); pg8::EpiBf<0> E{T, nullptr, nullptr, DM};
          pg8::gemm_phase<pg8::EpiBf<0>, pg8::StaticOrder, true, true>(lds, g, S, E);
          for (int rm_ = 0; rm_ < REP_MINI; ++rm_) mini_gemm<4>(lds, Z, (const bf16*)(wl + WO_MIX), DM, DM, MP, MS, E, vcu, G); }
        GRID_BAR();
#endif
#if (PHM >> 7) & 1
        if (l == 0) row_phase<false, true>(T, ARGIN(0), ARGIN(1), X, gl + 1 * DM, gl + 2 * DM, XN, gw, NGW, lane);
        else row_phase<true, true>(T, X, nullptr, X, gl + 1 * DM, gl + 2 * DM, XN, gw, NGW, lane);
        GRID_BAR();
#endif
#if (PHM >> 8) & 1
        { pg8::Gemm g{XN, (const bf16*)(wl + WO_Q), MP, DM, DM}; pg8::StaticOrder S; S.init(MP, DM, G, bx); pg8::EpiBf<0> E{Qb, nullptr, nullptr, DM};
          pg8::gemm_phase<pg8::EpiBf<0>, pg8::StaticOrder, true, true>(lds, g, S, E);
          for (int rm_ = 0; rm_ < REP_MINI; ++rm_) mini_gemm<4>(lds, XN, (const bf16*)(wl + WO_Q), DM, DM, MP, MS, E, vcu, G); }
        GRID_BAR();
#endif
#if (PHM >> 9) & 1
        for (int ra_ = 0; ra_ < REP_ATTN; ++ra_) {
          const bool sample_first = (vcu & 1) != 0;
          for (int ph = 0; ph < 2; ++ph) {
            if ((ph == 0) != sample_first) { for (int u = vcu; u < 512; u += G) attn_prompt_unit(lds, Qb, MKB + (size_t)l * MROWS * DM, MVT + (size_t)l * MROWS * DM, Ob, u >> 6, (u >> 4) & 3, u & 15); }
            else { const float* ck = ARGIN(5) + (size_t)l * DB * NMEM * DM; const float* cv = ARGIN(6) + (size_t)l * DB * NMEM * DM;
              for (int rs2_ = 0; rs2_ < REP_ATTS; ++rs2_) attn_sample_units(lds, Qb, ck, cv, Ob, vcu, G); }
          } }
        GRID_BAR();
#endif
#if (PHM >> 10) & 1
        { pg8::Gemm g{Ob, (const bf16*)(wl + WO_O), MP, DM, DM}; pg8::StaticOrder S; S.init(MP, DM, G, bx); pg8::EpiBf<0> E{T, nullptr, nullptr, DM};
          pg8::gemm_phase<pg8::EpiBf<0>, pg8::StaticOrder, true, true>(lds, g, S, E);
          for (int rm_ = 0; rm_ < REP_MINI; ++rm_) mini_gemm<4>(lds, Ob, (const bf16*)(wl + WO_O), DM, DM, MP, MS, E, vcu, G); }
        GRID_BAR();
#endif
#if (PHM >> 11) & 1
        row_phase<true, true>(T, X, nullptr, X, gl + 3 * DM, gl + 4 * DM, XN, gw, NGW, lane);
        GRID_BAR();
#endif
#if (PHM >> 12) & 1
        { pg8::Gemm g{XN, (const bf16*)(wl + WO_FI), MT, 2 * DFF, DM}; pg8::StaticOrder S; S.init(MT, 2 * DFF, G, bx); pg8::EpiSwiGLU E{ACT, DFF};
          pg8::gemm_phase<pg8::EpiSwiGLU, pg8::StaticOrder, true, true>(lds, g, S, E); }
        GRID_BAR();
#endif
#if (PHM >> 13) & 1
        { pg8::Gemm g{ACT, (const bf16*)(wl + WO_FO), MP, DM, DFF}; pg8::StaticOrder S; S.init(MP, DM, G, bx); pg8::EpiBf<0> E{T, nullptr, nullptr, DM};
          pg8::gemm_phase<pg8::EpiBf<0>, pg8::StaticOrder, true, true>(lds, g, S, E);
          for (int rm_ = 0; rm_ < REP_MINI; ++rm_) mini_gemm<11>(lds, ACT, (const bf16*)(wl + WO_FO), DFF, DM, MP, MS, E, vcu, G); }
        GRID_BAR();
#endif
#if (PHM >> 14) & 1
        if (l == DEPTH - 1) row_phase<true, false>(T, X, nullptr, out + OFF_Y, gl + 5 * DM, nullptr, nullptr, gw, NGW, lane);
        else row_phase<true, true>(T, X, nullptr, X, gl + 5 * DM, gains + (size_t)(l + 1) * 7 * DM, XN, gw, NGW, lane);
#endif
        if (l != DEPTH - 1) GRID_BAR();
    }
    if (G == 0x7ffffff0) cg::this_grid().sync();
}

#undef tid
#undef lane
#undef wave
#undef G
#undef bx
#undef vcu
#undef gw
#undef NGW
#undef ws
#undef out
#undef XN
#undef MN
#undef PROJ
#undef CA
#undef HS
#undef YC
#undef Z
#undef T
#undef X
#undef Qb
#undef Ob
#undef ACT
#undef MKB
#undef MVT
#undef gains
#undef wl
#undef gl
extern "C" void kernel_launch(void* const* d_in, const int* in_sizes, int n_in, void* d_out, int out_size, void* d_ws, size_t ws_size, hipStream_t stream) {
    static int grid = 0;
    if (grid == 0) {
        if (n_in != 26 || (size_t)out_size != OUT_TOTAL || ws_size < WS_END) { fprintf(stderr, "kernel_launch: unexpected shapes: n_in %d out %d ws %zu\n", n_in, out_size, ws_size); grid = -1; return; }
        int dev = 0, cus = 0, per_cu = 0;
        if (hipGetDevice(&dev) != hipSuccess || hipDeviceGetAttribute(&cus, hipDeviceAttributeMultiprocessorCount, dev) != hipSuccess) { grid = -1; return; }
        if (hipFuncSetAttribute((const void*)fwd_megakernel, hipFuncAttributeMaxDynamicSharedMemorySize, LDS_BYTES) != hipSuccess) { fprintf(stderr, "kernel_launch: hipFuncSetAttribute failed\n"); grid = -1; return; }
        if (hipOccupancyMaxActiveBlocksPerMultiprocessor(&per_cu, (const void*)fwd_megakernel, NWAVES * 64, LDS_BYTES) != hipSuccess || per_cu < 1) { fprintf(stderr, "kernel_launch: occupancy query says %d\n", per_cu); per_cu = 1; }
        (void)hipGetLastError();
        grid = cus;
    }
    if (grid < 0) return;
    (void)hipMemsetAsync((char*)d_ws + WS_CTL, 0, CTL_ZERO_BYTES, stream);
    Args a{};
    for (int i = 0; i < 26; ++i) a.in[i] = (const float*)d_in[i];
    a.out = (float*)d_out; a.ws = (unsigned char*)d_ws;
    void* kargs[] = {&a};
    hipError_t e = hipLaunchCooperativeKernel((const void*)fwd_megakernel, dim3(grid), dim3(NWAVES * 64), kargs, LDS_BYTES, stream);
    if (e != hipSuccess) fprintf(stderr, "kernel_launch: cooperative launch failed: %s (grid %d)\n", hipGetErrorString(e), grid);
}
```

```cpp
#include <hip/hip_runtime.h>
#include <hip/hip_cooperative_groups.h>
#include <cstdio>
#include <cstdint>
namespace cg = cooperative_groups;
#ifndef PHM
#define PHM 0xFFFFFF
#endif
#define CONVA_INTERLEAVE 1
#define REP_S1 1
#define REP_S2 1
#define REP_S3 1
#define REP_PRO 1
#define REP_ATTS 1
#define REP_ROW 1
#define REP_SCAN 1
#define REP_ATTN 1
#define REP_BAR 1
#define REP_MINI 1
namespace pg8 {
#define PG8_LAS __attribute__((address_space(3)))
typedef unsigned short bf16_t;
typedef short bf16x8 __attribute__((ext_vector_type(8)));
typedef float f32x4 __attribute__((ext_vector_type(4)));
typedef unsigned u32x4 __attribute__((ext_vector_type(4)));
constexpr int BM = 256, BK = 64, HALF = 128, HTB = HALF * BK * 2  , STAGE_BYTES = 8 * HTB, NXCD = 8, WGM = 8;

__host__ __device__ __forceinline__ int lds_byte(int r, int c) { const int st = (r >> 4) * 2 + (c >> 5), rr = r & 15, cc = c & 31, ob = rr * 64 + cc * 2; return st * 1024 + (ob ^ (((ob >> 9) & 1) << 5)); }
__host__ __device__ __forceinline__ void stage_rc(int b, int& R, int& C) { const int st = b / 1024, sb = b % 1024, swz = sb ^ (((sb >> 9) & 1) << 5); R = (st >> 1) * 16 + swz / 64; C = (st & 1) * 32 + (swz % 64) / 2; }
__host__ __device__ __forceinline__ int perm32(int rho) { const int n = rho >> 4, i = rho & 15; return 8 * (i >> 2) + 4 * n + (i & 3); }

struct Unit { int pm, pn; };
struct Gemm { const bf16_t* A; const bf16_t* Bt; int M, N, K; };

struct StaticOrder {
    int nM, nN, nwg, G, c;
    __host__ __device__ void init(int M, int N, int G_, int c_) { nM = M / BM; nN = N / BM; nwg = nM * nN; G = G_; c = c_; }
    __host__ __device__ bool next(int i, Unit& u) const {
        const long L = (long)i * G + c; if (L >= nwg) return false;
        int wgid = (int)L; { const int q = nwg / NXCD, r = nwg % NXCD, xcd = wgid % NXCD, off = wgid / NXCD; wgid = (xcd < r ? xcd * (q + 1) : r * (q + 1) + (xcd - r) * q) + off; }
        const int nig = WGM * nN, gid = wgid / nig, fm = gid * WGM, gsz = (nM - fm) < WGM ? (nM - fm) : WGM;
        u.pm = fm + ((wgid % nig) % gsz); u.pn = (wgid % nig) / gsz; return true;
    }
    __device__ __forceinline__ void a_ready(const Unit&) const {}
    __device__ __forceinline__ void done(const Unit&) const {}
};

typedef float f32x2_t __attribute__((ext_vector_type(2))); typedef __bf16 bf16x2_t __attribute__((ext_vector_type(2)));
__device__ __forceinline__ unsigned cvt_pk_bf16(float lo, float hi) { f32x2_t v = {lo, hi}; bf16x2_t b = __builtin_convertvector(v, bf16x2_t); return __builtin_bit_cast(unsigned, b); }
typedef unsigned u32x2 __attribute__((ext_vector_type(2)));
__device__ __forceinline__ float bflo(unsigned w) { return __uint_as_float(w << 16); }
__device__ __forceinline__ float bfhi(unsigned w) { return __uint_as_float(w & 0xffff0000u); }
__device__ __forceinline__ float sigmoidf_(float x) { return __builtin_amdgcn_rcpf(1.0f + __expf(-x)); }
__device__ __forceinline__ void st_bf16x4(bf16_t* p, f32x4 v) { u32x2 w; w.x = cvt_pk_bf16(v[0], v[1]); w.y = cvt_pk_bf16(v[2], v[3]); *(u32x2*)p = w; }
__device__ __forceinline__ f32x4 ld_bf16x4(const bf16_t* p) { const u32x2 w = *(const u32x2*)p; return (f32x4){bflo(w.x), bfhi(w.x), bflo(w.y), bfhi(w.y)}; }

typedef unsigned u32x4e __attribute__((ext_vector_type(4)));
__device__ __forceinline__ void st_bf16x8(bf16_t* p, f32x4 a, f32x4 b) { u32x4e w; w.x = cvt_pk_bf16(a[0], a[1]); w.y = cvt_pk_bf16(a[2], a[3]); w.z = cvt_pk_bf16(b[0], b[1]); w.w = cvt_pk_bf16(b[2], b[3]); *(u32x4e*)p = w; }
__device__ __forceinline__ void ld_bf16x8(const bf16_t* p, f32x4& a, f32x4& b) { const u32x4e w = *(const u32x4e*)p; a = (f32x4){bflo(w.x), bfhi(w.x), bflo(w.y), bfhi(w.y)}; b = (f32x4){bflo(w.z), bfhi(w.z), bflo(w.w), bfhi(w.w)}; }
template <int MODE> struct EpiBf {
    static constexpr bool PERM = true, AFTER_DRAIN = false;
    bf16_t* O; const bf16_t* mul; const bf16_t* add; int ldc;
    __device__ __forceinline__ void apply(int row, int col, f32x4 v) const { const size_t o = (size_t)row * ldc + col;
        if (MODE >= 1) v = v * ld_bf16x4(mul + o);
        if (MODE == 2) v = v + ld_bf16x4(add + o);
        st_bf16x4(O + o, v); }
    __device__ __forceinline__ void operator()(const f32x4 (&acc)[2][2][4][2], const Unit& u, int wr, int wc, int fr, int fq) const {
        const int row0 = u.pm * BM + wr * 64 + fr, col0 = u.pn * BM + wc * 32 + 8 * fq;
#pragma unroll
        for (int ai = 0; ai < 2; ++ai) {
            u32x4e gm[4][2], ga[4][2];
            if (MODE >= 1) {
#pragma unroll
                for (int m = 0; m < 4; ++m)
#pragma unroll
                    for (int bj = 0; bj < 2; ++bj) { const size_t o = (size_t)(row0 + ai * HALF + m * 16) * ldc + col0 + bj * HALF; gm[m][bj] = __builtin_nontemporal_load((const u32x4e*)(mul + o)); if (MODE == 2) ga[m][bj] = __builtin_nontemporal_load((const u32x4e*)(add + o)); } }
#pragma unroll
            for (int m = 0; m < 4; ++m) { const size_t ro = (size_t)(row0 + ai * HALF + m * 16) * ldc + col0;
#pragma unroll
                for (int bj = 0; bj < 2; ++bj) { const size_t o = ro + bj * HALF; f32x4 v0 = acc[ai][bj][m][0], v1 = acc[ai][bj][m][1];
                        if (MODE >= 1) { const u32x4e w = gm[m][bj]; v0 = v0 * (f32x4){bflo(w.x), bfhi(w.x), bflo(w.y), bfhi(w.y)}; v1 = v1 * (f32x4){bflo(w.z), bfhi(w.z), bflo(w.w), bfhi(w.w)}; }
                        if (MODE == 2) { const u32x4e w = ga[m][bj]; v0 = v0 + (f32x4){bflo(w.x), bfhi(w.x), bflo(w.y), bfhi(w.y)}; v1 = v1 + (f32x4){bflo(w.z), bfhi(w.z), bflo(w.w), bfhi(w.w)}; }
                        st_bf16x8(O + o, v0, v1); } }
            if (MODE >= 1) asm volatile("" ::: "memory"); }
    }
};
struct EpiF32 {
    static constexpr bool PERM = false, AFTER_DRAIN = false;
    float* O; int ldc;
    __device__ __forceinline__ void apply(int row, int col, f32x4 v) const { *(f32x4*)(O + (size_t)row * ldc + col) = v; }
    __device__ __forceinline__ void operator()(const f32x4 (&acc)[2][2][4][2], const Unit& u, int wr, int wc, int fr, int fq) const {
        const int row0 = u.pm * BM + wr * 64 + fr, col0 = u.pn * BM + wc * 32 + 4 * fq;
#pragma unroll
        for (int ai = 0; ai < 2; ++ai)
#pragma unroll
            for (int m = 0; m < 4; ++m) { const size_t ro = (size_t)(row0 + ai * HALF + m * 16) * ldc + col0;
#pragma unroll
                for (int bj = 0; bj < 2; ++bj)
#pragma unroll
                    for (int n = 0; n < 2; ++n) *(f32x4*)(O + ro + bj * HALF + n * 16) = acc[ai][bj][m][n]; }
    }
};
struct EpiInProj {
    static constexpr bool PERM = true, AFTER_DRAIN = false;
    bf16_t* P; size_t slot;
    __device__ __forceinline__ void operator()(const f32x4 (&acc)[2][2][4][2], const Unit& u, int wr, int wc, int fr, int fq) const {
        const int row0 = u.pm * BM + wr * 64 + fr; const int pn = u.pn;
        if (pn >= 4 && pn < 12) {
            bf16_t* base = P + slot; const int col0 = (pn - 4) * HALF + wc * 32 + 8 * fq;
#pragma unroll
            for (int ai = 0; ai < 2; ++ai)
#pragma unroll
                for (int m = 0; m < 4; ++m) { const size_t ro = (size_t)(row0 + ai * HALF + m * 16) * 1024 + col0;
                    st_bf16x8(base + ro, acc[ai][0][m][0] * acc[ai][1][m][0], acc[ai][0][m][1] * acc[ai][1][m][1]); }
        } else {
            int s, ct; if (pn < 4) { s = 0; ct = pn; } else if (pn < 16) { s = 2; ct = pn - 12; } else if (pn < 20) { s = 3; ct = pn - 16; } else { s = 4; ct = pn - 20; }
            bf16_t* base = P + (size_t)s * slot; const int col0 = ct * BM + wc * 32 + 8 * fq; const bool sg = (s >= 3);
#pragma unroll
            for (int ai = 0; ai < 2; ++ai)
#pragma unroll
                for (int m = 0; m < 4; ++m) { const size_t ro = (size_t)(row0 + ai * HALF + m * 16) * 1024 + col0;
#pragma unroll
                    for (int bj = 0; bj < 2; ++bj) { f32x4 v0 = acc[ai][bj][m][0], v1 = acc[ai][bj][m][1];
                            if (sg) {
#pragma unroll
                                for (int i = 0; i < 4; ++i) { v0[i] = sigmoidf_(v0[i]); v1[i] = sigmoidf_(v1[i]); } }
                            st_bf16x8(base + ro + bj * HALF, v0, v1); } }
        }
    }
};
struct EpiSwiGLU {
    static constexpr bool PERM = true, AFTER_DRAIN = false;
    bf16_t* O; int ldc;
    __device__ __forceinline__ void operator()(const f32x4 (&acc)[2][2][4][2], const Unit& u, int wr, int wc, int fr, int fq) const {
        const int row0 = u.pm * BM + wr * 64 + fr, col0 = u.pn * HALF + wc * 32 + 8 * fq;
#pragma unroll
        for (int ai = 0; ai < 2; ++ai)
#pragma unroll
            for (int m = 0; m < 4; ++m) { const size_t ro = (size_t)(row0 + ai * HALF + m * 16) * ldc + col0; f32x4 v[2];
#pragma unroll
                for (int n = 0; n < 2; ++n) { const f32x4 g = acc[ai][0][m][n], up = acc[ai][1][m][n];
#pragma unroll
                    for (int i = 0; i < 4; ++i) v[n][i] = g[i] * sigmoidf_(g[i]) * up[i]; }
                st_bf16x8(O + ro, v[0], v[1]); }
    }
};
struct EpiMemKV {
    static constexpr bool PERM = false, AFTER_DRAIN = false;
    float* outK; float* outV; bf16_t* KB; bf16_t* VT;
    __device__ __forceinline__ void operator()(const f32x4 (&acc)[2][2][4][2], const Unit& u, int wr, int wc, int fr, int fq) const {
        const int row0 = u.pm * BM + wr * 64 + fr; const bool isv = (u.pn >= 4); const int col0 = (u.pn & 3) * BM + wc * 32 + 4 * fq;
        float* of = isv ? outV : outK;
#pragma unroll
        for (int ai = 0; ai < 2; ++ai)
#pragma unroll
            for (int m = 0; m < 4; ++m) { const int row = row0 + ai * HALF + m * 16; const size_t ro = (size_t)row * 1024 + col0;
#pragma unroll
                for (int bj = 0; bj < 2; ++bj)
#pragma unroll
                    for (int n = 0; n < 2; ++n) { const f32x4 v = acc[ai][bj][m][n]; const size_t o = ro + bj * HALF + n * 16;
                        __builtin_nontemporal_store(v, (f32x4*)(of + o));
                        if (!isv) st_bf16x4(KB + o, v);
                        else { const int c = col0 + bj * HALF + n * 16; const int b = row >> 8, mm = row & 255;
                            bf16_t* vt = VT + ((size_t)(b * 1024 + c)) * 256 + mm;
                            const unsigned w0 = cvt_pk_bf16(v[0], v[1]), w1 = cvt_pk_bf16(v[2], v[3]);
                            vt[0] = (bf16_t)(w0 & 0xffffu); vt[256] = (bf16_t)(w0 >> 16); vt[512] = (bf16_t)(w1 & 0xffffu); vt[768] = (bf16_t)(w1 >> 16); } } }
    }
};

template <class Epi, class Sched, bool ALIGN_EPI = false, bool SP2 = false>
__device__ __forceinline__ void gemm_phase(PG8_LAS unsigned char* lds, const Gemm g, const Sched& S, const Epi& E) {
    int tid_o = threadIdx.x; asm volatile("" : "+v"(tid_o));
    const int tid = tid_o, wid = __builtin_amdgcn_readfirstlane(tid >> 6), lane = tid & 63, wr = wid >> 2, wc = wid & 3, fr = lane & 15, fq = lane >> 4;
    const int K = g.K, nt = K / BK;
    unsigned voffA[2], voffB[2];
#pragma unroll
    for (int i = 0; i < 2; ++i) { int R, C; stage_rc(tid * 16 + i * 8192, R, C); const int Rb = Epi::PERM ? ((R & ~31) + perm32(R & 31)) : R;
        voffA[i] = (unsigned)(R * K + C) * 2u; voffB[i] = (unsigned)(Rb * K + C) * 2u; }
    const size_t kstep = (size_t)(BK * 2);
    const size_t hstep = (size_t)HALF * K * 2;
    const size_t tstep = 2 * hstep;
    const unsigned ldsw = (unsigned)wid * 1024u;
    const int aoff = lds_byte(wr * 64 + fr, fq * 8), boff = lds_byte(wc * 32 + fr, fq * 8);
#define PG8_SA(b, h) (((b) * 2 + (h)) * HTB)
#define PG8_SB(b, h) ((4 + (b) * 2 + (h)) * HTB)
#define PG8_STAGE(bufoff, gbase, voff) do { _Pragma("unroll") for (int _i = 0; _i < 2; ++_i) \
        __builtin_amdgcn_global_load_lds((const unsigned*)((const char*)(gbase) + (voff)[_i]), (PG8_LAS unsigned*)(lds + (bufoff) + ldsw + _i * 8192), 16, 0, 0); } while (0)
#define PG8_LDA(dst, b, h) do { _Pragma("unroll") for (int m = 0; m < 4; ++m) _Pragma("unroll") for (int k = 0; k < 2; ++k) dst[m][k] = *(const PG8_LAS bf16x8*)(lds + PG8_SA(b, h) + aoff + m * 2048 + k * 1024); } while (0)
#define PG8_LDB(dst, b, h) do { _Pragma("unroll") for (int n = 0; n < 2; ++n) _Pragma("unroll") for (int k = 0; k < 2; ++k) dst[n][k] = *(const PG8_LAS bf16x8*)(lds + PG8_SB(b, h) + boff + n * 2048 + k * 1024); } while (0)
#define PG8_MMA(ai, bj, At, Bt) do { __builtin_amdgcn_s_setprio(1); _Pragma("unroll") for (int m = 0; m < 4; ++m) _Pragma("unroll") for (int n = 0; n < 2; ++n) _Pragma("unroll") for (int k = 0; k < 2; ++k) \
        acc[ai][bj][m][n] = __builtin_amdgcn_mfma_f32_16x16x32_bf16(Bt[n][k], At[m][k], acc[ai][bj][m][n], 0, 0, 0); __builtin_amdgcn_s_setprio(0); } while (0)
#define PG8_WAIT_V(n) asm volatile("s_waitcnt vmcnt(" #n ")" ::: "memory")
#define PG8_WAIT_L(n) asm volatile("s_waitcnt lgkmcnt(" #n ")" ::: "memory")
#define PG8_BAR __builtin_amdgcn_s_barrier()
#define PG8_SCHED __builtin_amdgcn_sched_barrier(0)
    Unit cur, nxt; int ui = 0;
    if (!S.next(0, cur)) return;
    f32x4 acc[2][2][4][2];
#pragma unroll
    for (int a = 0; a < 2; ++a)
#pragma unroll
        for (int b = 0; b < 2; ++b)
#pragma unroll
            for (int m = 0; m < 4; ++m)
#pragma unroll
                for (int n = 0; n < 2; ++n) acc[a][b][m][n] = (f32x4){0.f, 0.f, 0.f, 0.f};
    bf16x8 At[4][2], B0[2][2], B1[2][2];
    const char* cA = (const char*)g.A + (size_t)cur.pm * tstep; const char* cB = (const char*)g.Bt + (size_t)cur.pn * tstep;
    S.a_ready(cur);
    if constexpr (SP2) {
        PG8_STAGE(PG8_SB(0, 0), cB, voffB); PG8_STAGE(PG8_SB(0, 1), cB + hstep, voffB); PG8_STAGE(PG8_SA(0, 0), cA, voffA); PG8_STAGE(PG8_SA(0, 1), cA + hstep, voffA);
        if (wr == 1) PG8_BAR;
        PG8_WAIT_V(2); PG8_BAR;
        PG8_STAGE(PG8_SB(1, 0), cB + kstep, voffB); PG8_STAGE(PG8_SA(1, 0), cA + kstep, voffA); PG8_STAGE(PG8_SB(1, 1), cB + hstep + kstep, voffB);
        PG8_WAIT_V(6); PG8_BAR;
    } else {
        PG8_STAGE(PG8_SB(0, 0), cB, voffB); PG8_STAGE(PG8_SA(0, 0), cA, voffA); PG8_STAGE(PG8_SB(0, 1), cB + hstep, voffB); PG8_STAGE(PG8_SA(0, 1), cA + hstep, voffA);
        if (wr == 1) PG8_BAR;
        PG8_WAIT_V(4); PG8_BAR;
        PG8_STAGE(PG8_SB(1, 0), cB + kstep, voffB); PG8_STAGE(PG8_SA(1, 0), cA + kstep, voffA); PG8_STAGE(PG8_SB(1, 1), cB + hstep + kstep, voffB);
        PG8_WAIT_V(6); PG8_BAR;
    }
    for (;;) {
        const bool has_next = S.next(ui + 1, nxt);
        const char* nA = has_next ? (const char*)g.A + (size_t)nxt.pm * tstep : cA; const char* nB = has_next ? (const char*)g.Bt + (size_t)nxt.pn * tstep : cB;
        for (int t = 0; t < nt; t += 2) {
            const bool last = (t == nt - 2);
            const char* a1 = cA + (size_t)(t + 1) * kstep;
            const char* a2 = last ? nA : cA + (size_t)(t + 2) * kstep; const char* b2 = last ? nB : cB + (size_t)(t + 2) * kstep;
            const char* a3 = a2 + kstep; const char* b3 = b2 + kstep;
            if (last && has_next) S.a_ready(nxt);
            if constexpr (SP2) {
            PG8_LDB(B0, 0, 0); PG8_LDB(B1, 0, 1); PG8_SCHED; PG8_LDA(At, 0, 0); PG8_STAGE(PG8_SA(1, 1), a1 + hstep, voffA);
            PG8_WAIT_V(8); PG8_WAIT_L(0); PG8_BAR; PG8_MMA(0, 0, At, B0); PG8_MMA(0, 1, At, B1); PG8_BAR; PG8_SCHED;
            PG8_LDA(At, 0, 1); PG8_STAGE(PG8_SB(0, 0), b2, voffB); PG8_STAGE(PG8_SB(0, 1), b2 + hstep, voffB); PG8_STAGE(PG8_SA(0, 0), a2, voffA);
            PG8_WAIT_V(8); PG8_WAIT_L(0); PG8_BAR; PG8_MMA(1, 0, At, B0); PG8_MMA(1, 1, At, B1); PG8_BAR; PG8_SCHED;
            PG8_LDB(B0, 1, 0); PG8_LDB(B1, 1, 1); PG8_SCHED; PG8_LDA(At, 1, 0); PG8_STAGE(PG8_SA(0, 1), a2 + hstep, voffA);
            PG8_WAIT_V(8); PG8_WAIT_L(0); PG8_BAR; PG8_MMA(0, 0, At, B0); PG8_MMA(0, 1, At, B1); PG8_BAR; PG8_SCHED;
            PG8_LDA(At, 1, 1); PG8_STAGE(PG8_SB(1, 0), b3, voffB); PG8_STAGE(PG8_SB(1, 1), b3 + hstep, voffB); PG8_STAGE(PG8_SA(1, 0), a3, voffA);
            PG8_WAIT_V(8); PG8_WAIT_L(0); PG8_BAR; PG8_MMA(1, 0, At, B0); PG8_MMA(1, 1, At, B1); PG8_BAR; PG8_SCHED;
            } else {
            PG8_LDB(B0, 0, 0); PG8_SCHED; PG8_LDA(At, 0, 0); PG8_STAGE(PG8_SA(1, 1), a1 + hstep, voffA);
            PG8_WAIT_L(8); PG8_BAR; PG8_WAIT_L(0); PG8_MMA(0, 0, At, B0); PG8_BAR; PG8_SCHED;
            PG8_LDB(B1, 0, 1); PG8_STAGE(PG8_SB(0, 0), b2, voffB);
            PG8_BAR; PG8_WAIT_L(0); PG8_MMA(0, 1, At, B1); PG8_BAR;
            PG8_LDA(At, 0, 1); PG8_STAGE(PG8_SA(0, 0), a2, voffA);
            PG8_BAR; PG8_WAIT_L(0); PG8_MMA(1, 0, At, B0); PG8_BAR; PG8_SCHED;
            PG8_STAGE(PG8_SB(0, 1), b2 + hstep, voffB);
            PG8_WAIT_V(6); PG8_BAR; PG8_MMA(1, 1, At, B1); PG8_BAR;
            PG8_LDB(B0, 1, 0); PG8_SCHED; PG8_LDA(At, 1, 0); PG8_STAGE(PG8_SA(0, 1), a2 + hstep, voffA);
            PG8_WAIT_L(8); PG8_BAR; PG8_WAIT_L(0); PG8_MMA(0, 0, At, B0); PG8_BAR; PG8_SCHED;
            PG8_LDB(B1, 1, 1); PG8_STAGE(PG8_SB(1, 0), b3, voffB);
            PG8_BAR; PG8_WAIT_L(0); PG8_MMA(0, 1, At, B1); PG8_BAR;
            PG8_LDA(At, 1, 1); PG8_STAGE(PG8_SA(1, 0), a3, voffA);
            PG8_BAR; PG8_WAIT_L(0); PG8_MMA(1, 0, At, B0); PG8_BAR; PG8_SCHED;
            PG8_STAGE(PG8_SB(1, 1), b3 + hstep, voffB);
            PG8_WAIT_V(6); PG8_BAR; PG8_MMA(1, 1, At, B1); PG8_BAR;
            }
        }
        if constexpr (ALIGN_EPI) { if (wr == 0) PG8_BAR; }
        if constexpr (!Epi::AFTER_DRAIN) { E(acc, cur, wr, wc, fr, fq); S.done(cur); }
        if (!has_next) break;
#pragma unroll
        for (int a = 0; a < 2; ++a)
#pragma unroll
            for (int b = 0; b < 2; ++b)
#pragma unroll
                for (int m = 0; m < 4; ++m)
#pragma unroll
                    for (int n = 0; n < 2; ++n) acc[a][b][m][n] = (f32x4){0.f, 0.f, 0.f, 0.f};
        cur = nxt; cA = nA; cB = nB; ++ui;
        if constexpr (ALIGN_EPI) { if (wr == 1) PG8_BAR; }
    }
    PG8_WAIT_V(0);
    if constexpr (!ALIGN_EPI) { if (wr == 0) PG8_BAR; }
    PG8_BAR;
    if constexpr (Epi::AFTER_DRAIN) { E.fused(acc, cur, wr, wc, fr, fq, lds, wid, lane); S.done(cur); }
#undef PG8_SA
#undef PG8_SB
#undef PG8_STAGE
#undef PG8_LDA
#undef PG8_LDB
#undef PG8_MMA
#undef PG8_WAIT_V
#undef PG8_WAIT_L
#undef PG8_BAR
#undef PG8_SCHED
}
}

constexpr int NWAVES = 8;
constexpr int DM = 1024, NB = 8, SEQ = 2048, DEPTH = 2, DB = 128, DSEQ = 8, NMEM = 256, NH = 4, HD = 256, DFF = 2816, DIN = 6144;
constexpr int MP = NB * SEQ, MS = DB * DSEQ, MT = MP + MS;
constexpr int MROWS = NB * NMEM;
constexpr float EPS = 1e-6f;
constexpr size_t MiB = 1u << 20;
constexpr size_t WS_CTL = 0, CTL_ZERO_BYTES = 64 * 1024;
constexpr size_t WS_W = 2 * MiB, W_LAYER = 44 * MiB;
constexpr size_t WO_IN = 0, WO_CO = 12 * MiB, WO_RO = 14 * MiB, WO_MIX = 16 * MiB, WO_KV = 18 * MiB, WO_Q = 22 * MiB, WO_O = 24 * MiB, WO_FI = 26 * MiB, WO_FO = 37 * MiB;
constexpr size_t WS_XN = 92 * MiB;
constexpr size_t WS_MN = 128 * MiB;
constexpr size_t WS_PROJ = 138 * MiB;
constexpr size_t WS_CA = 310 * MiB, WS_HS = 346 * MiB, WS_YC = 382 * MiB, WS_Z = 418 * MiB;
constexpr size_t WS_T = 454 * MiB, WS_X = 524 * MiB;
constexpr size_t WS_Q = 594 * MiB, WS_O = 630 * MiB;
constexpr size_t WS_ACT = 666 * MiB;
constexpr size_t WS_MKB = 762 * MiB, WS_MVT = 772 * MiB;
constexpr size_t WS_END = 782 * MiB;
constexpr size_t SLOT = (size_t)MT * DM;
constexpr size_t OFF_Y = 0, OFF_PCA = (size_t)MT * DM, OFF_PCB = OFF_PCA + 2 * 8 * 2 * 1024, OFF_PH = OFF_PCB + 2 * 8 * 3 * 1024, OFF_PK = OFF_PH + 2 * 8 * 1024,
                 OFF_PV = OFF_PK + (size_t)2 * MROWS * DM, OFF_SA = OFF_PV + (size_t)2 * MROWS * DM, OFF_SB = OFF_SA + 2 * 128 * 2 * 1024, OFF_SH = OFF_SB + 2 * 128 * 3 * 1024,
                 OUT_TOTAL = OFF_SH + 2 * 128 * 1024;
constexpr int CW_BAR = 1024;
constexpr int LDS_BYTES = 147456;
constexpr int MISC_OFF = 146432;

#define GAS __attribute__((address_space(1)))
#define LAS __attribute__((address_space(3)))
typedef unsigned short bf16;
typedef unsigned v4u __attribute__((ext_vector_type(4)));
typedef unsigned v2u __attribute__((ext_vector_type(2)));
typedef float f32x4 __attribute__((ext_vector_type(4)));
typedef short bf16x8 __attribute__((ext_vector_type(8)));
#define LDS_WAIT() asm volatile("s_waitcnt lgkmcnt(0)" ::: "memory")
using pg8::cvt_pk_bf16; using pg8::bflo; using pg8::bfhi; using pg8::sigmoidf_;
__device__ __forceinline__ float wave_sum(float v) {
#pragma unroll
    for (int o = 1; o < 64; o <<= 1) v += __shfl_xor(v, o);
    return v;
}
#define XB_TMO      128
#define XB_XCNT(j)  (256  + 64 * (j))
#define XB_XSUB(j)  (1280 + 64 * (j))
#define XB_XGEN(j)  (2304 + 64 * (j))
#define XB_TOP      3328
#define XB_TOPGEN   3392
#define XCD_BAR_WORDS 3456
#define XB_SPIN_CAP (1u << 18)

__device__ __forceinline__ unsigned xb_ld(unsigned* p)              { return __hip_atomic_load(p, __ATOMIC_RELAXED, __HIP_MEMORY_SCOPE_AGENT); }
__device__ __forceinline__ unsigned xb_add(unsigned* p, unsigned v) { return __hip_atomic_fetch_add(p, v, __ATOMIC_RELAXED, __HIP_MEMORY_SCOPE_AGENT); }
__device__ __forceinline__ unsigned xb_xcc_id() { return (unsigned)__builtin_amdgcn_s_getreg((3 << 11) | 20) & 0xFu; }
#define XB_SPIN(cond, bar) do { unsigned _sp = 0; while (cond) { __builtin_amdgcn_s_sleep(1); \
    if ((++_sp & 255u) == 0u) { if (xb_ld(&(bar)[XB_TMO])) break; if (_sp > XB_SPIN_CAP) { atomicAdd(&(bar)[XB_TMO], 1u); break; } } } } while (0)

struct XcdBarrier {
    unsigned* bar; unsigned x;
    volatile LAS unsigned* st;
};

__device__ __forceinline__ XcdBarrier xcd_barrier_post(unsigned* bar, volatile LAS unsigned* st) {
    XcdBarrier b; b.bar = bar; b.x = xb_xcc_id(); b.st = st;
    if (threadIdx.x == 0) (void)xb_add(&bar[XB_XCNT(b.x)], 1u);
    return b;
}
__device__ __forceinline__ void xcd_barrier_complete(unsigned* bar, unsigned x, unsigned& nloc, unsigned& nx) {
    const unsigned G = gridDim.x * gridDim.y * gridDim.z;
    unsigned sum, cnt, mine, sp = 0u;
    for (;;) {
        sum = 0u; cnt = 0u; mine = 0u;
#pragma unroll
        for (unsigned j = 0; j < 16; ++j) { const unsigned c = xb_ld(&bar[XB_XCNT(j)]); sum += c; cnt += (c > 0u) ? 1u : 0u; mine = (j == x) ? c : mine; }
        if (sum == G) break;
        __builtin_amdgcn_s_sleep(1);
        if ((++sp & 255u) == 0u) { if (xb_ld(&bar[XB_TMO])) break; if (sp > XB_SPIN_CAP) { atomicAdd(&bar[XB_TMO], 1u); break; } }
    }
    nloc = mine > 0u ? mine : 1u; nx = cnt > 0u ? cnt : 1u;
}

__device__ __forceinline__ void xcd_barrier(const XcdBarrier& b) {
    asm volatile("s_waitcnt vmcnt(0)" ::: "memory");
    __syncthreads();
    if (threadIdx.x == 0) {
        unsigned* bar = b.bar;
        __builtin_amdgcn_s_waitcnt(0);
        unsigned nloc = b.st[0], nx = b.st[1];
        if (nloc == 0u) { xcd_barrier_complete(bar, b.x, nloc, nx); b.st[0] = nloc; b.st[1] = nx; }
        const unsigned old = xb_add(&bar[XB_XSUB(b.x)], 1u);
        const unsigned gen = old / nloc;
        if (old + 1u == (gen + 1u) * nloc) {
            __builtin_amdgcn_fence(__ATOMIC_RELEASE, "agent");
            asm volatile("s_waitcnt vmcnt(0)" ::: "memory");
            const unsigned og = xb_add(&bar[XB_TOP], 1u);
            const unsigned tg = og / nx;
            if (og + 1u == (tg + 1u) * nx) xb_add(&bar[XB_TOPGEN], 1u);
            else XB_SPIN(xb_ld(&bar[XB_TOPGEN]) == tg, bar);
            __builtin_amdgcn_fence(__ATOMIC_ACQUIRE, "agent");
            xb_add(&bar[XB_XGEN(b.x)], 1u);
            asm volatile("s_waitcnt vmcnt(0)" ::: "memory");
        } else {
            XB_SPIN(xb_ld(&bar[XB_XGEN(b.x)]) == gen, bar);
            __builtin_amdgcn_fence(__ATOMIC_ACQUIRE, "agent");
            asm volatile("s_waitcnt vmcnt(0)" ::: "memory");
        }
    }
    __syncthreads();
}

__device__ __forceinline__ int map_row(int mapid, int n) {
    if (mapid == 1) { const int seg = n >> 10, c = n & 1023;
        if (seg == 0) return c; if (seg == 1) return 1024 + (c >> 7) * 256 + (c & 127); if (seg == 2) return 1024 + (c >> 7) * 256 + 128 + (c & 127);
        return 3072 + (seg - 3) * 1024 + c; }
    if (mapid == 2) { if (n < DFF) return (n >> 7) * 256 + (n & 127); const int c = n - DFF; return (c >> 7) * 256 + 128 + (c & 127); }
    return n;
}
__device__ __forceinline__ void transpose_item(const float* W, int K, int N, bf16* WT, int mapid, LAS float* scr, int item, int lane) {
    const int nblk = N / 32, kb = item / nblk, nb = item % nblk, k0 = 64 * kb, n0 = 32 * nb;
#pragma unroll 8
    for (int i = 0; i < 32; ++i) { const int kk = 2 * i + (lane >> 5); scr[kk * 33 + (lane & 31)] = __builtin_nontemporal_load(W + (size_t)(k0 + kk) * N + n0 + (lane & 31)); }
    LDS_WAIT(); asm volatile("" ::: "memory");
    const int c = lane & 7; const int r0 = map_row(mapid, n0);
#pragma unroll
    for (int j = 0; j < 4; ++j) { const int n = (lane >> 3) + 8 * j; const LAS float* s = scr + (8 * c) * 33 + n;
        v4u o; o.x = cvt_pk_bf16(s[0 * 33], s[1 * 33]); o.y = cvt_pk_bf16(s[2 * 33], s[3 * 33]); o.z = cvt_pk_bf16(s[4 * 33], s[5 * 33]); o.w = cvt_pk_bf16(s[6 * 33], s[7 * 33]);
        *(v4u*)(WT + (size_t)(r0 + n) * K + k0 + 8 * c) = o; }
    LDS_WAIT(); asm volatile("" ::: "memory");
}
__device__ __forceinline__ void rms_row_to_bf16(const float* xrow, const float* g, bf16* orow, int lane) {
    const f32x4* xr = (const f32x4*)xrow + lane; const f32x4* gr = (const f32x4*)g + lane;
    f32x4 v[4]; float s = 0.f;
#pragma unroll
    for (int j = 0; j < 4; ++j) { v[j] = xr[64 * j]; s += (v[j].x * v[j].x + v[j].y * v[j].y) + (v[j].z * v[j].z + v[j].w * v[j].w); }
    const float rs = 1.0f / sqrtf(wave_sum(s) * (1.f / DM) + EPS);
    v2u* o8 = (v2u*)orow + lane;
#pragma unroll
    for (int j = 0; j < 4; ++j) { const f32x4 gg = gr[64 * j]; v2u w; w.x = cvt_pk_bf16(v[j].x * rs * gg.x, v[j].y * rs * gg.y); w.y = cvt_pk_bf16(v[j].z * rs * gg.z, v[j].w * rs * gg.w); o8[64 * j] = w; }
}
template <bool XIN_BF, bool XOUT_BF> __device__ __forceinline__ void row_phase(const bf16* T, const void* xinA, const void* xinB, void* xout, const float* gpost, const float* gpre, bf16* XN, int gw_, int NGW_, int lane_) {
    asm volatile("" : "+v"(lane_));
    f32x4 gp[4], gn[4];
#pragma unroll
    for (int j = 0; j < 4; ++j) { gp[j] = ((const f32x4*)gpost)[lane_ + 64 * j]; gn[j] = gpre ? ((const f32x4*)gpre)[lane_ + 64 * j] : (f32x4){0.f, 0.f, 0.f, 0.f}; }
    for (int r = gw_; r < MT; r += NGW_) {
        const v2u* tr = (const v2u*)(T + (size_t)r * DM) + lane_;
        f32x4 t[4], x[4]; float s = 0.f;
#pragma unroll
        for (int j = 0; j < 4; ++j) { const v2u w = __builtin_nontemporal_load(tr + 64 * j); t[j] = (f32x4){bflo(w.x), bfhi(w.x), bflo(w.y), bfhi(w.y)}; s += (t[j].x * t[j].x + t[j].y * t[j].y) + (t[j].z * t[j].z + t[j].w * t[j].w); }
        if (XIN_BF) { const v2u* xr = (const v2u*)((const bf16*)xinA + (size_t)r * DM) + lane_;
#pragma unroll
            for (int j = 0; j < 4; ++j) { const v2u w = __builtin_nontemporal_load(xr + 64 * j); x[j] = (f32x4){bflo(w.x), bfhi(w.x), bflo(w.y), bfhi(w.y)}; } }
        else { const f32x4* xr = (const f32x4*)((r < MP) ? (const float*)xinA + (size_t)r * DM : (const float*)xinB + (size_t)(r - MP) * DM) + lane_;
#pragma unroll
            for (int j = 0; j < 4; ++j) x[j] = xr[64 * j]; }
        const float rs = 1.0f / sqrtf(wave_sum(s) * (1.f / DM) + EPS);
        float s2 = 0.f;
#pragma unroll
        for (int j = 0; j < 4; ++j) { x[j] = x[j] + t[j] * rs * gp[j]; s2 += (x[j].x * x[j].x + x[j].y * x[j].y) + (x[j].z * x[j].z + x[j].w * x[j].w); }
        if (XOUT_BF) { v2u* xo = (v2u*)((bf16*)xout + (size_t)r * DM) + lane_;
#pragma unroll
            for (int j = 0; j < 4; ++j) { v2u w; w.x = cvt_pk_bf16(x[j].x, x[j].y); w.y = cvt_pk_bf16(x[j].z, x[j].w); __builtin_nontemporal_store(w, xo + 64 * j); } }
        else { f32x4* xo = (f32x4*)((float*)xout + (size_t)r * DM) + lane_;
#pragma unroll
            for (int j = 0; j < 4; ++j) __builtin_nontemporal_store(x[j], xo + 64 * j); }
        if (XN) { const float rs2 = 1.0f / sqrtf(wave_sum(s2) * (1.f / DM) + EPS); v2u* o8 = (v2u*)(XN + (size_t)r * DM) + lane_;
#pragma unroll
            for (int j = 0; j < 4; ++j) { v2u w; w.x = cvt_pk_bf16(x[j].x * rs2 * gn[j].x, x[j].y * rs2 * gn[j].y); w.y = cvt_pk_bf16(x[j].z * rs2 * gn[j].z, x[j].w * rs2 * gn[j].w); o8[64 * j] = w; } }
    }
}

struct LayerIn { const float *sca, *scb, *sh, *caw, *cbw, *cbb, *wga, *bga, *wgx, *bgx, *lam; };
__device__ __forceinline__ float fsig(float x) { return __builtin_amdgcn_rcpf(1.0f + __expf(-x)); }
struct ConvA { const bf16* HB; const bf16* G; bf16* CA; float* pca; float* sa; };
__device__ __forceinline__ void bf8_to_f(const v4u w, float* g) { g[0] = bflo(w.x); g[1] = bfhi(w.x); g[2] = bflo(w.y); g[3] = bfhi(w.y); g[4] = bflo(w.z); g[5] = bfhi(w.z); g[6] = bflo(w.w); g[7] = bfhi(w.w); }
struct ConvAReg { v4u w0, wh, w1, w2; };
__device__ __forceinline__ void conva_load(const ConvA& C, int it, ConvAReg& R) {
        const int r = it >> 7, c = (it & 127) * 8;
        const int t = (r < MP) ? (r & (SEQ - 1)) : ((r - MP) & 7);
        R.w0 = *(const v4u*)(C.G + (size_t)r * DM + c); R.wh = *(const v4u*)(C.HB + (size_t)r * DM + c);
        R.w1 = *(const v4u*)(C.G + (size_t)(r - (t >= 1 ? 1 : 0)) * DM + c); R.w2 = *(const v4u*)(C.G + (size_t)(r - (t >= 2 ? 2 : 0)) * DM + c);
}
__device__ __forceinline__ void conva_finish(const ConvA& C, const LayerIn& L, int it, const ConvAReg& R) {
        const int r = it >> 7, c = (it & 127) * 8;
        int t, b, TL; const bool smp = (r >= MP);
        if (!smp) { t = r & (SEQ - 1); b = r >> 11; TL = SEQ; } else { const int s = r - MP; t = s & 7; b = s >> 3; TL = DSEQ; }
        float g0[8], g1[8], g2[8], hb[8];
        bf8_to_f(R.w0, g0); bf8_to_f(R.wh, hb); bf8_to_f(R.w1, g1); bf8_to_f(R.w2, g2);
        if (t < 2) {
            if (smp) { const float* p2 = L.sca + ((size_t)b * 2 + t) * DM + c;
#pragma unroll
                for (int i = 0; i < 8; ++i) g2[i] = p2[i];
                if (t < 1) { const float* p1 = L.sca + ((size_t)b * 2 + 1) * DM + c;
#pragma unroll
                    for (int i = 0; i < 8; ++i) g1[i] = p1[i]; } }
            else {
#pragma unroll
                for (int i = 0; i < 8; ++i) { g2[i] = 0.f; if (t < 1) g1[i] = 0.f; } }
        }
        const f32x4 c0a = *(const f32x4*)(L.caw + c), c0b = *(const f32x4*)(L.caw + c + 4), c1a = *(const f32x4*)(L.caw + DM + c), c1b = *(const f32x4*)(L.caw + DM + c + 4), c2a = *(const f32x4*)(L.caw + 2 * DM + c), c2b = *(const f32x4*)(L.caw + 2 * DM + c + 4);
        float y[8];
#pragma unroll
        for (int i = 0; i < 8; ++i) { const float k0 = i < 4 ? c0a[i & 3] : c0b[i & 3], k1 = i < 4 ? c1a[i & 3] : c1b[i & 3], k2 = i < 4 ? c2a[i & 3] : c2b[i & 3]; y[i] = hb[i] * (k0 * g2[i] + k1 * g1[i] + k2 * g0[i]); }
        v4u o; o.x = cvt_pk_bf16(y[0], y[1]); o.y = cvt_pk_bf16(y[2], y[3]); o.z = cvt_pk_bf16(y[4], y[5]); o.w = cvt_pk_bf16(y[6], y[7]);
        *(v4u*)(C.CA + (size_t)r * DM + c) = o;
        if (t >= TL - 2) { float* dst = (smp ? C.sa : C.pca) + ((size_t)b * 2 + (t - (TL - 2))) * DM + c;
            *(f32x4*)dst = (f32x4){g0[0], g0[1], g0[2], g0[3]}; *(f32x4*)(dst + 4) = (f32x4){g0[4], g0[5], g0[6], g0[7]}; }
}
__device__ __forceinline__ void conva_item(const ConvA& C, const LayerIn& L, int it) { ConvAReg R; conva_load(C, it, R); conva_finish(C, L, it, R); }

constexpr int SC_UE = 0;
constexpr int SC_UCB = 45056;
constexpr int SC_UCF = 65536;
constexpr int SC_AA = 83968;
constexpr int SC_BB = 100352;
constexpr int SC_SEGA = 116736;
constexpr int SC_SEGB = 118784;
constexpr int SC_HIN = 120832;
constexpr int SC_HOUT = 122880;
constexpr int SC_WGT = 131072;
__device__ __forceinline__ void scan_unit(LAS unsigned char* lds, const bf16* U, bf16* HS, const LayerIn& L, float* pcb, float* ph, float* sb, float* sh, int kind, int sidx, int cgi, const ConvA& CV, int& cv_it, int cv_stride) {
    int tid_ = threadIdx.x; asm volatile("" : "+v"(tid_));
    const int tid = tid_, lane = tid & 63, w = tid >> 6, fr = lane & 15, fq = lane >> 4;
    const int nblk = cgi >> 1, cgh = cgi & 1, c0 = nblk * 64, cm0 = c0 + 32 * cgh;
    LAS float* UE = (LAS float*)(lds + SC_UE); LAS bf16* UCB = (LAS bf16*)(lds + SC_UCB); LAS float* UCF = (LAS float*)(lds + SC_UCF);
    LAS float* AA = (LAS float*)(lds + SC_AA); LAS float* BB = (LAS float*)(lds + SC_BB); LAS float* SEGA = (LAS float*)(lds + SC_SEGA);
    LAS float* SEGB = (LAS float*)(lds + SC_SEGB); LAS float* HIN = (LAS float*)(lds + SC_HIN); LAS bf16* HOUT = (LAS bf16*)(lds + SC_HOUT);
    LAS v4u* WGT = (LAS v4u*)(lds + SC_WGT);
#pragma unroll
    for (int nt = 0; nt < 2; ++nt)
#pragma unroll
        for (int ks = 0; ks < 2; ++ks) { const int j = 32 * cgh + 16 * nt + fr; const float* pa = L.wga + ((size_t)nblk * 64 + 32 * ks + 8 * fq) * 64 + j; const float* px = L.wgx + ((size_t)nblk * 64 + 32 * ks + 8 * fq) * 64 + j;
            unsigned a0 = cvt_pk_bf16(pa[0], pa[64]), a1 = cvt_pk_bf16(pa[128], pa[192]), a2 = cvt_pk_bf16(pa[256], pa[320]), a3 = cvt_pk_bf16(pa[384], pa[448]);
            unsigned x0 = cvt_pk_bf16(px[0], px[64]), x1 = cvt_pk_bf16(px[128], px[192]), x2 = cvt_pk_bf16(px[256], px[320]), x3 = cvt_pk_bf16(px[384], px[448]);
            v4u va = {a0, a1, a2, a3}, vx = {x0, x1, x2, x3};
            WGT[((nt * 2 + ks) * 2 + 0) * 64 + lane] = va; WGT[((nt * 2 + ks) * 2 + 1) * 64 + lane] = vx; }
    float ba[2], bx[2], sp8[2];
#pragma unroll
    for (int nt = 0; nt < 2; ++nt) { const int ch = cm0 + 16 * nt + fr; ba[nt] = L.bga[ch]; bx[nt] = L.bgx[ch]; sp8[nt] = 8.0f * log1pf(expf(-L.lam[ch])); }
    const int cgq = lane & 15;
    const f32x4 cw0 = *(const f32x4*)(L.cbw + c0 + 4 * cgq), cw1 = *(const f32x4*)(L.cbw + DM + c0 + 4 * cgq), cw2 = *(const f32x4*)(L.cbw + 2 * DM + c0 + 4 * cgq), cw3 = *(const f32x4*)(L.cbw + 3 * DM + c0 + 4 * cgq), cbias = *(const f32x4*)(L.cbb + c0 + 4 * cgq);
    float carry[2] = {0.f, 0.f};
    const int nch = (kind == 0) ? SEQ / 128 : 1;
    v4u pre0 = {0u, 0u, 0u, 0u}, pre1 = pre0, pre2 = pre0;
    int pt_[3], pc_[3], pl_[3];
#pragma unroll
    for (int i = 0; i < 3; ++i) { const int idx_ = tid + 512 * i, seg_ = idx_ / 88, rem_ = idx_ - seg_ * 88, j_ = rem_ >> 3, c8_ = rem_ & 7; pt_[i] = seg_ * 8 + j_ - 3; pc_[i] = c0 + 8 * c8_; pl_[i] = (seg_ * 11 + j_) * 64 + 8 * c8_; }
    const bool p2ok = tid < 1408 - 1024;
#define SC_PIECE(i, ckk, dstv) do { if ((i) < 2 || p2ok) { const int t_ = (ckk) * 128 + pt_[i]; \
        const v4u ld_ = *(const v4u*)(U + ((size_t)sidx * SEQ + (t_ < 0 ? 0 : t_)) * DM + pc_[i]); dstv = (t_ < 0) ? (v4u){0u, 0u, 0u, 0u} : ld_; } } while (0)
#define SC_PUT(i, srcv) do { if ((i) < 2 || p2ok) { LAS float* d_ = UE + pl_[i]; \
        *(LAS f32x4*)d_ = (f32x4){bflo(srcv.x), bfhi(srcv.x), bflo(srcv.y), bfhi(srcv.y)}; *(LAS f32x4*)(d_ + 4) = (f32x4){bflo(srcv.z), bfhi(srcv.z), bflo(srcv.w), bfhi(srcv.w)}; } } while (0)
    if (kind == 0) { SC_PIECE(0, 0, pre0); SC_PIECE(1, 0, pre1); SC_PIECE(2, 0, pre2); }
    for (int ck = 0; ck < nch; ++ck) {
        if (kind == 0) {
            SC_PUT(0, pre0); SC_PUT(1, pre1); SC_PUT(2, pre2);
            if (ck + 1 < nch) { SC_PIECE(0, ck + 1, pre0); SC_PIECE(1, ck + 1, pre1); SC_PIECE(2, ck + 1, pre2); }
        } else {
        for (int idx = tid; idx < 16 * 11 * 8; idx += 512) {
            const int seg = idx / 88, rem = idx - seg * 88, j = rem >> 3, c8 = rem & 7; float v[8];
            const int sq = sidx * 16 + seg;
            if (j < 3) { const float* p = L.scb + ((size_t)sq * 3 + j) * DM + c0 + 8 * c8; const f32x4 p0 = *(const f32x4*)p, p1 = *(const f32x4*)(p + 4);
                    v[0] = p0.x; v[1] = p0.y; v[2] = p0.z; v[3] = p0.w; v[4] = p1.x; v[5] = p1.y; v[6] = p1.z; v[7] = p1.w; }
            else { const v4u wv = *(const v4u*)(U + ((size_t)MP + sq * 8 + (j - 3)) * DM + c0 + 8 * c8); v[0] = bflo(wv.x); v[1] = bfhi(wv.x); v[2] = bflo(wv.y); v[3] = bfhi(wv.y); v[4] = bflo(wv.z); v[5] = bfhi(wv.z); v[6] = bflo(wv.w); v[7] = bfhi(wv.w); }
            LAS float* d = UE + (seg * 11 + j) * 64 + 8 * c8;
            *(LAS f32x4*)d = (f32x4){v[0], v[1], v[2], v[3]}; *(LAS f32x4*)(d + 4) = (f32x4){v[4], v[5], v[6], v[7]};
        }
        }
#if CONVA_INTERLEAVE
        ConvAReg cvr; const int cv_cur = cv_it; const bool cv_do = cv_cur < MT * 128;
        if (cv_do) { conva_load(CV, cv_cur, cvr); cv_it += cv_stride; }
#endif
        __syncthreads();
        for (int r1_ = 0; r1_ < REP_S1; ++r1_)
        { const int tk0 = 16 * w + 4 * fq, seg = tk0 >> 3, tt0 = tk0 & 7; const LAS float* p = UE + (seg * 11 + tt0) * 64 + 4 * cgq;
          f32x4 ur[7];
#pragma unroll
          for (int j = 0; j < 7; ++j) ur[j] = *(const LAS f32x4*)(p + 64 * j);
#pragma unroll
          for (int i = 0; i < 4; ++i) { const f32x4 uc = cbias + cw0 * ur[i] + cw1 * ur[i + 1] + cw2 * ur[i + 2] + cw3 * ur[i + 3];
              v2u pk; pk.x = cvt_pk_bf16(uc.x, uc.y); pk.y = cvt_pk_bf16(uc.z, uc.w); *(LAS v2u*)(UCB + (tk0 + i) * 80 + 4 * cgq) = pk;
              if ((cgq >> 3) == cgh) *(LAS f32x4*)(UCF + (tk0 + i) * 36 + 4 * (cgq & 7)) = uc; } }
        if (kind == 1 || ck == nch - 1)
        for (int idx = tid; idx < 16 * 3 * 32; idx += 512) { const int seg = idx / 96, jj = (idx >> 5) % 3, c = idx & 31; const float val = UE[(seg * 11 + 8 + jj) * 64 + 32 * cgh + c];
            if (kind == 1) sb[((size_t)(sidx * 16 + seg) * 3 + jj) * DM + cm0 + c] = val;
            else if (ck == nch - 1 && seg == 15) pcb[((size_t)sidx * 3 + jj) * DM + cm0 + c] = val; }
        LDS_WAIT(); asm volatile("" ::: "memory");
        f32x4 ra[2], rx[2];
        { bf16x8 af[2];
#pragma unroll
          for (int ks = 0; ks < 2; ++ks) af[ks] = *(const LAS bf16x8*)(UCB + (16 * w + fr) * 80 + 32 * ks + 8 * fq);
#pragma unroll
          for (int nt = 0; nt < 2; ++nt) { ra[nt] = (f32x4){0.f, 0.f, 0.f, 0.f}; rx[nt] = (f32x4){0.f, 0.f, 0.f, 0.f};
#pragma unroll
              for (int ks = 0; ks < 2; ++ks) { const bf16x8 wa_ = __builtin_bit_cast(bf16x8, WGT[((nt * 2 + ks) * 2 + 0) * 64 + lane]), wx_ = __builtin_bit_cast(bf16x8, WGT[((nt * 2 + ks) * 2 + 1) * 64 + lane]);
                  ra[nt] = __builtin_amdgcn_mfma_f32_16x16x32_bf16(af[ks], wa_, ra[nt], 0, 0, 0); rx[nt] = __builtin_amdgcn_mfma_f32_16x16x32_bf16(af[ks], wx_, rx[nt], 0, 0, 0); } } }
        float Ap[2][4], Bp[2][4], eA[2], eB[2], At[2], Bt[2];
#pragma unroll
        for (int nt = 0; nt < 2; ++nt) {
#pragma unroll
            for (int rg = 0; rg < 4; ++rg) { const int tk = 16 * w + 4 * fq + rg, c = 16 * nt + fr; const float uc = UCF[tk * 36 + c];
                const float r = fsig(ra[nt][rg] + ba[nt]), ii = fsig(rx[nt][rg] + bx[nt]); const float la = -sp8[nt] * r;
                const float av = __expf(la), bv = __builtin_amdgcn_sqrtf(fmaxf(1.0f - av * av, 0.f)) * ii * uc;
                if (rg == 0) { Ap[nt][0] = av; Bp[nt][0] = bv; } else { Ap[nt][rg] = av * Ap[nt][rg - 1]; Bp[nt][rg] = av * Bp[nt][rg - 1] + bv; } }
            float A_ = Ap[nt][3], B_ = Bp[nt][3];
            { const float pA = __shfl_up(A_, 16), pB = __shfl_up(B_, 16); const bool c1 = (kind == 0) ? (fq >= 1) : ((fq & 1) != 0); if (c1) { B_ = A_ * pB + B_; A_ = pA * A_; } }
            if (kind == 0) { const float pA = __shfl_up(A_, 32), pB = __shfl_up(B_, 32); if (fq >= 2) { B_ = A_ * pB + B_; A_ = pA * A_; } }
            { float xA = __shfl_up(A_, 16), xB = __shfl_up(B_, 16); const bool first = (kind == 0) ? (fq == 0) : ((fq & 1) == 0); if (first) { xA = 1.f; xB = 0.f; } eA[nt] = xA; eB[nt] = xB; }
            At[nt] = A_; Bt[nt] = B_;
        }
        float hst[2];
        if (kind == 0) {
            typedef float f32x2s __attribute__((ext_vector_type(2)));
            LAS f32x2s* SW = (LAS f32x2s*)(lds + SC_SEGA) + (ck & 1) * 256;
            if (fq == 3) { SW[w * 32 + fr] = (f32x2s){At[0], Bt[0]}; SW[w * 32 + 16 + fr] = (f32x2s){At[1], Bt[1]}; }
            __syncthreads();
#pragma unroll
            for (int nt = 0; nt < 2; ++nt) { float h = carry[nt], hin = 0.f;
#pragma unroll
                for (int ww = 0; ww < 8; ++ww) { const f32x2s ab = SW[ww * 32 + 16 * nt + fr]; if (ww == w) hin = h; h = ab.x * h + ab.y; }
                carry[nt] = h; hst[nt] = eA[nt] * hin + eB[nt]; }
        } else {
#pragma unroll
            for (int nt = 0; nt < 2; ++nt) { const float hin = L.sh[(size_t)(sidx * 16 + 2 * w + (fq >> 1)) * DM + cm0 + 16 * nt + fr]; hst[nt] = eA[nt] * hin + eB[nt]; }
        }
#pragma unroll
        for (int nt = 0; nt < 2; ++nt) {
#pragma unroll
            for (int rg = 0; rg < 4; ++rg) { const float h = Ap[nt][rg] * hst[nt] + Bp[nt][rg]; HOUT[(16 * w + 4 * fq + rg) * 32 + 16 * nt + fr] = (bf16)(cvt_pk_bf16(h, 0.f) & 0xffffu);
                if (rg == 3 && kind == 1 && (fq & 1)) sh[(size_t)(sidx * 16 + 2 * w + (fq >> 1)) * DM + cm0 + 16 * nt + fr] = h; }
            if (kind == 0 && ck == nch - 1 && w == 0 && fq == 0) ph[(size_t)sidx * DM + cm0 + 16 * nt + fr] = carry[nt];
        }
        LDS_WAIT(); asm volatile("" ::: "memory");
        for (int r3_ = 0; r3_ < REP_S3; ++r3_)
        { const int row = tid >> 2, part = tid & 3; const v4u v = *(const LAS v4u*)(HOUT + row * 32 + part * 8);
          const size_t grow = (kind == 0) ? (size_t)sidx * SEQ + ck * 128 + row : (size_t)MP + (size_t)sidx * 128 + row;
          *(v4u*)(HS + grow * DM + cm0 + part * 8) = v; }
#if CONVA_INTERLEAVE
        if (cv_do) conva_finish(CV, L, cv_cur, cvr);
#endif
    }
    __syncthreads();
#undef SC_PIECE
#undef SC_PUT
}

constexpr int KSTP = 272;
constexpr int KSTR = 264;
constexpr float SM_C = 0.0625f * 1.4426950408889634f;
__device__ __forceinline__ void attn_prompt_unit(LAS unsigned char* lds, const bf16* Q, const bf16* KB, const bf16* VT, bf16* O, int b, int h, int qt) {
    int tid_ = threadIdx.x; asm volatile("" : "+v"(tid_));
    const int tid = tid_, lane = tid & 63, w = tid >> 6, fr = lane & 15, fq = lane >> 4;
    LAS bf16* TL = (LAS bf16*)lds; LAS bf16* PW = (LAS bf16*)(lds + 64 * KSTP * 2 + w * (16 * KSTP * 2));
    const size_t qrow0 = (size_t)b * SEQ + qt * 128 + 16 * w;
    const int pm_ = tid >> 5, pc_ = (tid & 31) * 8;
    const bf16* ksrc = KB + ((size_t)b * NMEM + pm_) * DM + h * HD + pc_;
    const bf16* vsrc = VT + ((size_t)(b * NH + h) * HD + pm_) * NMEM + pc_;
    v4u nx0, nx1, nx2, nx3;
#define AT_LOADK(jt) do { const bf16* p_ = ksrc + (size_t)(64 * (jt)) * DM; nx0 = *(const v4u*)p_; nx1 = *(const v4u*)(p_ + 16 * DM); nx2 = *(const v4u*)(p_ + 32 * DM); nx3 = *(const v4u*)(p_ + 48 * DM); } while (0)
#define AT_LOADV(jt) do { const bf16* p_ = vsrc + (size_t)(64 * (jt)) * NMEM; nx0 = *(const v4u*)p_; nx1 = *(const v4u*)(p_ + 16 * NMEM); nx2 = *(const v4u*)(p_ + 32 * NMEM); nx3 = *(const v4u*)(p_ + 48 * NMEM); } while (0)
#define AT_PUT() do { LAS bf16* d_ = TL + pm_ * KSTP + pc_; *(LAS v4u*)d_ = nx0; *(LAS v4u*)(d_ + 16 * KSTP) = nx1; *(LAS v4u*)(d_ + 32 * KSTP) = nx2; *(LAS v4u*)(d_ + 48 * KSTP) = nx3; } while (0)
    AT_LOADK(0);
    bf16x8 qf[8];
#pragma unroll
    for (int ks = 0; ks < 8; ++ks) qf[ks] = *(const bf16x8*)(Q + (qrow0 + fr) * DM + h * HD + 32 * ks + 8 * fq);
    f32x4 s[16];
#pragma unroll
    for (int i = 0; i < 16; ++i) s[i] = (f32x4){0.f, 0.f, 0.f, 0.f};
#pragma unroll
    for (int jt = 0; jt < 4; ++jt) {
        AT_PUT();
        __syncthreads();
        if (jt < 3) AT_LOADK(jt + 1); else AT_LOADV(0);
        { bf16x8 fb[2][8];
#pragma unroll
          for (int ks = 0; ks < 8; ++ks) fb[0][ks] = *(const LAS bf16x8*)(TL + fr * KSTP + 32 * ks + 8 * fq);
#pragma unroll
          for (int nt = 0; nt < 4; ++nt) {
              if (nt < 3) {
#pragma unroll
                  for (int ks = 0; ks < 8; ++ks) fb[(nt + 1) & 1][ks] = *(const LAS bf16x8*)(TL + (16 * (nt + 1) + fr) * KSTP + 32 * ks + 8 * fq); }
              __builtin_amdgcn_sched_barrier(0); __builtin_amdgcn_s_setprio(1);
#pragma unroll
              for (int ks = 0; ks < 8; ++ks) s[4 * jt + nt] = __builtin_amdgcn_mfma_f32_16x16x32_bf16(fb[nt & 1][ks], qf[ks], s[4 * jt + nt], 0, 0, 0);
              __builtin_amdgcn_s_setprio(0); __builtin_amdgcn_sched_barrier(0);
          } }
        __syncthreads();
    }
    { float mx = s[0][0];
#pragma unroll
      for (int nt = 0; nt < 16; ++nt) mx = fmaxf(fmaxf(mx, fmaxf(s[nt][0], s[nt][1])), fmaxf(s[nt][2], s[nt][3]));
      mx = fmaxf(mx, __shfl_xor(mx, 16)); mx = fmaxf(mx, __shfl_xor(mx, 32));
      float sum = 0.f;
#pragma unroll
      for (int nt = 0; nt < 16; ++nt)
#pragma unroll
          for (int rg = 0; rg < 4; ++rg) { const float p = exp2f((s[nt][rg] - mx) * SM_C); s[nt][rg] = p; sum += p; }
      sum += __shfl_xor(sum, 16); sum += __shfl_xor(sum, 32);
      const float inv = 1.0f / sum;
#pragma unroll
      for (int nt = 0; nt < 16; ++nt) { v2u pk; pk.x = cvt_pk_bf16(s[nt][0] * inv, s[nt][1] * inv); pk.y = cvt_pk_bf16(s[nt][2] * inv, s[nt][3] * inv); *(LAS v2u*)(PW + fr * KSTP + 16 * nt + 4 * fq) = pk; } }
    LDS_WAIT(); asm volatile("" ::: "memory");
    bf16x8 pf[8];
#pragma unroll
    for (int ks = 0; ks < 8; ++ks) pf[ks] = *(const LAS bf16x8*)(PW + fr * KSTP + 32 * ks + 8 * fq);
#pragma unroll
    for (int jt = 0; jt < 4; ++jt) {
        AT_PUT();
        __syncthreads();
        if (jt < 3) AT_LOADV(jt + 1);
        { bf16x8 fb[2][8];
#pragma unroll
          for (int ks = 0; ks < 8; ++ks) fb[0][ks] = *(const LAS bf16x8*)(TL + fr * KSTP + 32 * ks + 8 * fq);
#pragma unroll
          for (int nt = 0; nt < 4; ++nt) { f32x4 o = (f32x4){0.f, 0.f, 0.f, 0.f};
              if (nt < 3) {
#pragma unroll
                  for (int ks = 0; ks < 8; ++ks) fb[(nt + 1) & 1][ks] = *(const LAS bf16x8*)(TL + (16 * (nt + 1) + fr) * KSTP + 32 * ks + 8 * fq); }
              __builtin_amdgcn_sched_barrier(0); __builtin_amdgcn_s_setprio(1);
#pragma unroll
              for (int ks = 0; ks < 8; ++ks) o = __builtin_amdgcn_mfma_f32_16x16x32_bf16(fb[nt & 1][ks], pf[ks], o, 0, 0, 0);
              __builtin_amdgcn_s_setprio(0); __builtin_amdgcn_sched_barrier(0);
              v2u pk; pk.x = cvt_pk_bf16(o[0], o[1]); pk.y = cvt_pk_bf16(o[2], o[3]);
              *(v2u*)(O + (qrow0 + fr) * DM + h * HD + 64 * jt + 16 * nt + 4 * fq) = pk; } }
        __syncthreads();
    }
#undef AT_LOADK
#undef AT_LOADV
#undef AT_PUT
}
__device__ __forceinline__ void attn_sample_units(LAS unsigned char* lds, const bf16* Q, const float* CK, const float* CV, bf16* O, int first, int stride) {
    int tid_ = threadIdx.x; asm volatile("" : "+v"(tid_));
    const int tid = tid_, lane = tid & 63, w = tid >> 6, fr = lane & 15, fq = lane >> 4;
    LAS bf16* KS = (LAS bf16*)lds; LAS bf16* PS = (LAS bf16*)(lds + 135168); LAS float* RED = (LAS float*)(lds + 143616);
    constexpr int KPF = 8;
    f32x4 kp[KPF];
#define AS_KBASE(u_) (CK + ((size_t)((u_) >> 2) * NMEM * NH + ((u_) & 3)) * HD)
#define AS_KLOAD(u_) do { const float* kb_ = AS_KBASE(u_); _Pragma("unroll") for (int i = 0; i < KPF; ++i) { const int idx = i * 512 + tid, m = idx >> 6, d4 = idx & 63; kp[i] = __builtin_nontemporal_load((const f32x4*)(kb_ + (size_t)m * DM + 4 * d4)); } } while (0)
    int u = first;
    if (u < 512) AS_KLOAD(u);
    for (; u < 512; u += stride) {
        const int b = u >> 2, h = u & 3;
        const float* kbase = AS_KBASE(u);
        const float* vbase = CV + ((size_t)b * NMEM * NH + h) * HD;
#pragma unroll
        for (int i = 0; i < KPF; ++i) { const int idx = i * 512 + tid, m = idx >> 6, d4 = idx & 63; v2u o; o.x = cvt_pk_bf16(kp[i].x, kp[i].y); o.y = cvt_pk_bf16(kp[i].z, kp[i].w); *(LAS v2u*)(KS + m * KSTR + 4 * d4) = o; }
#pragma unroll 8
        for (int i = KPF; i < 32; ++i) { const int idx = i * 512 + tid, m = idx >> 6, d4 = idx & 63; const f32x4 v = __builtin_nontemporal_load((const f32x4*)(kbase + (size_t)m * DM + 4 * d4));
            v2u o; o.x = cvt_pk_bf16(v.x, v.y); o.y = cvt_pk_bf16(v.z, v.w); *(LAS v2u*)(KS + m * KSTR + 4 * d4) = o; }
        bf16x8 qf[8];
#pragma unroll
        for (int ks = 0; ks < 8; ++ks) { if (fr < 8) qf[ks] = *(const bf16x8*)(Q + ((size_t)MP + b * DSEQ + fr) * DM + h * HD + 32 * ks + 8 * fq); else qf[ks] = (bf16x8){0, 0, 0, 0, 0, 0, 0, 0}; }
        __syncthreads();
        f32x4 vp[16];
#pragma unroll
        for (int i = 0; i < 8; ++i) { const int mp = i * 8 + (lane & 7), d4 = w * 8 + (lane >> 3);
            vp[2 * i] = __builtin_nontemporal_load((const f32x4*)(vbase + (size_t)(2 * mp) * DM + 4 * d4)); vp[2 * i + 1] = __builtin_nontemporal_load((const f32x4*)(vbase + (size_t)(2 * mp + 1) * DM + 4 * d4)); }
        f32x4 s[2];
#pragma unroll
        for (int nt = 0; nt < 2; ++nt) { s[nt] = (f32x4){0.f, 0.f, 0.f, 0.f};
#pragma unroll
            for (int ks = 0; ks < 8; ++ks) { const bf16x8 bfr = *(const LAS bf16x8*)(KS + (32 * w + 16 * nt + fr) * KSTR + 32 * ks + 8 * fq); s[nt] = __builtin_amdgcn_mfma_f32_16x16x32_bf16(bfr, qf[ks], s[nt], 0, 0, 0); } }
        { float m_ = fmaxf(fmaxf(fmaxf(s[0][0], s[0][1]), fmaxf(s[0][2], s[0][3])), fmaxf(fmaxf(s[1][0], s[1][1]), fmaxf(s[1][2], s[1][3])));
          m_ = fmaxf(m_, __shfl_xor(m_, 16)); m_ = fmaxf(m_, __shfl_xor(m_, 32));
          if (fq == 0) RED[w * 16 + fr] = m_; }
        __syncthreads();
        { float m_ = RED[fr];
#pragma unroll
          for (int ww = 1; ww < 8; ++ww) m_ = fmaxf(m_, RED[ww * 16 + fr]);
          float sum = 0.f;
#pragma unroll
          for (int nt = 0; nt < 2; ++nt)
#pragma unroll
              for (int rg = 0; rg < 4; ++rg) { const float p = exp2f((s[nt][rg] - m_) * SM_C); s[nt][rg] = p; sum += p; }
          sum += __shfl_xor(sum, 16); sum += __shfl_xor(sum, 32);
          if (fq == 0) RED[128 + w * 16 + fr] = sum; }
#pragma unroll
        for (int i = 0; i < 8; ++i) { const int mp = i * 8 + (lane & 7), d4 = w * 8 + (lane >> 3); const f32x4 v0 = vp[2 * i], v1 = vp[2 * i + 1];
            LAS unsigned* dst = (LAS unsigned*)(KS + (4 * d4) * KSTR + 2 * mp);
            dst[0] = cvt_pk_bf16(v0.x, v1.x); dst[KSTR / 2] = cvt_pk_bf16(v0.y, v1.y); dst[KSTR] = cvt_pk_bf16(v0.z, v1.z); dst[3 * KSTR / 2] = cvt_pk_bf16(v0.w, v1.w); }
#pragma unroll 4
        for (int i = 8; i < 16; ++i) { const int mp = i * 8 + (lane & 7), d4 = w * 8 + (lane >> 3);
            const f32x4 v0 = __builtin_nontemporal_load((const f32x4*)(vbase + (size_t)(2 * mp) * DM + 4 * d4)), v1 = __builtin_nontemporal_load((const f32x4*)(vbase + (size_t)(2 * mp + 1) * DM + 4 * d4));
            LAS unsigned* dst = (LAS unsigned*)(KS + (4 * d4) * KSTR + 2 * mp);
            dst[0] = cvt_pk_bf16(v0.x, v1.x); dst[KSTR / 2] = cvt_pk_bf16(v0.y, v1.y); dst[KSTR] = cvt_pk_bf16(v0.z, v1.z); dst[3 * KSTR / 2] = cvt_pk_bf16(v0.w, v1.w); }
        __syncthreads();
        { float tot = RED[128 + fr];
#pragma unroll
          for (int ww = 1; ww < 8; ++ww) tot += RED[128 + ww * 16 + fr];
          const float inv = 1.0f / tot;
#pragma unroll
          for (int nt = 0; nt < 2; ++nt) { v2u pk; pk.x = cvt_pk_bf16(s[nt][0] * inv, s[nt][1] * inv); pk.y = cvt_pk_bf16(s[nt][2] * inv, s[nt][3] * inv); *(LAS v2u*)(PS + fr * KSTR + 32 * w + 16 * nt + 4 * fq) = pk; } }
        __syncthreads();
        if (u + stride < 512) AS_KLOAD(u + stride);
#pragma unroll
        for (int nt = 0; nt < 2; ++nt) { f32x4 o = (f32x4){0.f, 0.f, 0.f, 0.f};
#pragma unroll
            for (int ks = 0; ks < 8; ++ks) { const bf16x8 pfr = *(const LAS bf16x8*)(PS + fr * KSTR + 32 * ks + 8 * fq); const bf16x8 bfr = *(const LAS bf16x8*)(KS + (32 * w + 16 * nt + fr) * KSTR + 32 * ks + 8 * fq);
                o = __builtin_amdgcn_mfma_f32_16x16x32_bf16(bfr, pfr, o, 0, 0, 0); }
            if (fr < 8) { v2u pk; pk.x = cvt_pk_bf16(o[0], o[1]); pk.y = cvt_pk_bf16(o[2], o[3]); *(v2u*)(O + ((size_t)MP + b * DSEQ + fr) * DM + h * HD + 32 * w + 16 * nt + 4 * fq) = pk; } }
        __syncthreads();
    }
#undef AS_KBASE
#undef AS_KLOAD
}
template <int KS, class Epi> __device__ __forceinline__ void mini_gemm(LAS unsigned char* lds, const bf16* A, const bf16* Bt, int K, int N, int row_base, int nrows, const Epi& E, int first, int stride) {
    int tid_ = threadIdx.x; asm volatile("" : "+v"(tid_));
    const int lane = tid_ & 63, w = tid_ >> 6, fr = lane & 15, fq = lane >> 4;
    const int ntn = N / 64, ntiles = (nrows / 64) * ntn;
    LAS f32x4* RED = (LAS f32x4*)lds;
    for (int t = first; t < ntiles; t += stride) {
        const int tm = t / ntn, tn = t - tm * ntn;
        const int r0 = row_base + tm * 64, c0 = tn * 64;
        const bf16* ap = A + (size_t)(r0 + fr) * K + 8 * fq + 32 * w * KS;
        const bf16* bp = Bt + (size_t)(c0 + fr) * K + 8 * fq + 32 * w * KS;
        f32x4 acc[4][4];
#pragma unroll
        for (int i = 0; i < 4; ++i)
#pragma unroll
            for (int j = 0; j < 4; ++j) acc[i][j] = (f32x4){0.f, 0.f, 0.f, 0.f};
#pragma unroll
        for (int k0 = 0; k0 < KS; k0 += 4) { bf16x8 a[4][4], b[4][4];
#pragma unroll
            for (int kk = 0; kk < 4; ++kk) if (k0 + kk < KS) {
#pragma unroll
                for (int i = 0; i < 4; ++i) { a[kk][i] = *(const bf16x8*)(ap + (size_t)(16 * i) * K + 32 * (k0 + kk)); b[kk][i] = *(const bf16x8*)(bp + (size_t)(16 * i) * K + 32 * (k0 + kk)); } }
            __builtin_amdgcn_sched_barrier(0);
#pragma unroll
            for (int kk = 0; kk < 4; ++kk) if (k0 + kk < KS) {
#pragma unroll
                for (int i = 0; i < 4; ++i)
#pragma unroll
                    for (int j = 0; j < 4; ++j) acc[i][j] = __builtin_amdgcn_mfma_f32_16x16x32_bf16(b[kk][j], a[kk][i], acc[i][j], 0, 0, 0); }
            __builtin_amdgcn_sched_barrier(0);
        }
#pragma unroll
        for (int i = 0; i < 4; ++i)
#pragma unroll
            for (int j = 0; j < 4; ++j) RED[(w * 16 + i * 4 + j) * 64 + lane] = acc[i][j];
        __syncthreads();
#pragma unroll
        for (int q = 0; q < 2; ++q) { const int st = 2 * w + q, mt = st >> 2, nt = st & 3; f32x4 v = RED[st * 64 + lane];
#pragma unroll
            for (int ww = 1; ww < 8; ++ww) v = v + RED[(ww * 16 + st) * 64 + lane];
            E.apply(r0 + 16 * mt + fr, c0 + 16 * nt + 4 * fq, v); }
        __syncthreads();
    }
}

__device__ __forceinline__ void mini_gemm_dual(LAS unsigned char* lds, const bf16* A1, const bf16* B1, const bf16* A2, const bf16* B2, const bf16* m1, const bf16* m2, bf16* Zo, int row_base, int nrows, int first, int stride) {
    int tid_ = threadIdx.x; asm volatile("" : "+v"(tid_));
    const int lane = tid_ & 63, w = tid_ >> 6, fr = lane & 15, fq = lane >> 4;
    constexpr int K = DM, KS = 4; const int ntn = DM / 64, ntiles = (nrows / 64) * ntn;
    LAS f32x4* RED = (LAS f32x4*)lds;
    for (int t = first; t < ntiles; t += stride) {
        const int tm = t / ntn, tn = t - tm * ntn;
        const int r0 = row_base + tm * 64, c0 = tn * 64;
        f32x4 zkeep[2];
#pragma unroll
        for (int pass = 0; pass < 2; ++pass) {
            const bf16* ap = (pass ? A2 : A1) + (size_t)(r0 + fr) * K + 8 * fq + 32 * w * KS;
            const bf16* bp = (pass ? B2 : B1) + (size_t)(c0 + fr) * K + 8 * fq + 32 * w * KS;
            f32x4 acc[4][4];
#pragma unroll
            for (int i = 0; i < 4; ++i)
#pragma unroll
                for (int j = 0; j < 4; ++j) acc[i][j] = (f32x4){0.f, 0.f, 0.f, 0.f};
            bf16x8 a[4][4], b[4][4];
#pragma unroll
            for (int kk = 0; kk < 4; ++kk)
#pragma unroll
                for (int i = 0; i < 4; ++i) { a[kk][i] = *(const bf16x8*)(ap + (size_t)(16 * i) * K + 32 * kk); b[kk][i] = *(const bf16x8*)(bp + (size_t)(16 * i) * K + 32 * kk); }
            __builtin_amdgcn_sched_barrier(0);
#pragma unroll
            for (int kk = 0; kk < 4; ++kk)
#pragma unroll
                for (int i = 0; i < 4; ++i)
#pragma unroll
                    for (int j = 0; j < 4; ++j) acc[i][j] = __builtin_amdgcn_mfma_f32_16x16x32_bf16(b[kk][j], a[kk][i], acc[i][j], 0, 0, 0);
            __builtin_amdgcn_sched_barrier(0);
#pragma unroll
            for (int i = 0; i < 4; ++i)
#pragma unroll
                for (int j = 0; j < 4; ++j) RED[(w * 16 + i * 4 + j) * 64 + lane] = acc[i][j];
            __syncthreads();
#pragma unroll
            for (int q = 0; q < 2; ++q) { const int st = 2 * w + q, mt = st >> 2, nt = st & 3; f32x4 v = RED[st * 64 + lane];
#pragma unroll
                for (int ww = 1; ww < 8; ++ww) v = v + RED[(ww * 16 + st) * 64 + lane];
                const size_t o = (size_t)(r0 + 16 * mt + fr) * DM + c0 + 16 * nt + 4 * fq;
                if (pass == 0) { zkeep[q] = v * pg8::ld_bf16x4(m1 + o); }
                else { pg8::st_bf16x4(Zo + o, zkeep[q] + v * pg8::ld_bf16x4(m2 + o)); } }
            __syncthreads();
        }
    }
}

struct Args { const float* in[26]; float* out; unsigned char* ws; };
typedef __attribute__((address_space(4))) const unsigned char* karg_t;
__device__ __forceinline__ const float* karg_in(int i) { karg_t p = (karg_t)__builtin_amdgcn_kernarg_segment_ptr(); asm volatile("" : "+s"(p)); return *(const float* __attribute__((address_space(4))) const*)(p + 8 * i); }
__device__ __forceinline__ float* karg_out() { karg_t p = (karg_t)__builtin_amdgcn_kernarg_segment_ptr(); asm volatile("" : "+s"(p)); return *(float* __attribute__((address_space(4))) const*)(p + 8 * 26); }
__device__ __forceinline__ unsigned char* karg_ws() { karg_t p = (karg_t)__builtin_amdgcn_kernarg_segment_ptr(); asm volatile("" : "+s"(p)); return *(unsigned char* __attribute__((address_space(4))) const*)(p + 8 * 27); }
#define ARGIN(i) karg_in(i)
__device__ __forceinline__ int opaque_i(int v) { asm volatile("" : "+s"(v)); return v; }
__device__ __forceinline__ int vcu_of(int g, int b) { return (g % 8 == 0) ? (b % 8) * (g / 8) + b / 8 : b; }
__global__ void __launch_bounds__(NWAVES * 64, 2) fwd_megakernel(Args args_unused) {
    extern __shared__ __attribute__((aligned(16))) unsigned char lds_raw[];
    LAS unsigned char* lds = (LAS unsigned char*)lds_raw;
#define tid ((int)threadIdx.x)
#define lane (tid & 63)
#define wave (__builtin_amdgcn_readfirstlane(tid >> 6))
#define G (opaque_i((int)gridDim.x))
#define bx ((int)blockIdx.x)
#define vcu (vcu_of(G, bx))
    for (int u = tid; u < 256; u += NWAVES * 64) ((LAS unsigned*)(lds + MISC_OFF))[u] = 0u;
    __syncthreads();
    XcdBarrier bar = xcd_barrier_post((unsigned*)(karg_ws() + WS_CTL) + CW_BAR, (volatile LAS unsigned*)(lds + MISC_OFF) + 8);
#define GRID_BAR() do { for (int rb_ = 0; rb_ < REP_BAR; ++rb_) xcd_barrier(bar); } while (0)
#define gw (vcu * NWAVES + wave)
#define NGW (G * NWAVES)
#define ws (karg_ws())
#define out (karg_out())
#define XN ((bf16*)(ws + WS_XN))
#define MN ((bf16*)(ws + WS_MN))
#define PROJ ((bf16*)(ws + WS_PROJ))
#define CA ((bf16*)(ws + WS_CA))
#define HS ((bf16*)(ws + WS_HS))
#define YC ((bf16*)(ws + WS_YC))
#define Z ((bf16*)(ws + WS_Z))
#define T ((bf16*)(ws + WS_T))
#define X ((bf16*)(ws + WS_X))
#define Qb ((bf16*)(ws + WS_Q))
#define Ob ((bf16*)(ws + WS_O))
#define ACT ((bf16*)(ws + WS_ACT))
#define MKB ((bf16*)(ws + WS_MKB))
#define MVT ((bf16*)(ws + WS_MVT))
#define gains (ARGIN(8))
#if (PHM >> 0) & 1
    for (int rp_ = 0; rp_ < REP_PRO; ++rp_) {
        LAS float* scr = (LAS float*)(lds + wave * 16384);
        constexpr int NIT = 10880;
        for (int it = gw; it < 2 * NIT; it += NGW) {
            const int l = it / NIT; int r = it - l * NIT; bf16* wb = (bf16*)(ws + WS_W + (size_t)l * W_LAYER);
            if (r < 3072) { transpose_item(ARGIN(9) + (size_t)l * DM * DIN, DM, DIN, (bf16*)((unsigned char*)wb + WO_IN), 1, scr, r, lane); continue; } r -= 3072;
            if (r < 512) { transpose_item(ARGIN(11) + (size_t)l * DM * DM, DM, DM, (bf16*)((unsigned char*)wb + WO_CO), 0, scr, r, lane); continue; } r -= 512;
            if (r < 512) { transpose_item(ARGIN(19) + (size_t)l * DM * DM, DM, DM, (bf16*)((unsigned char*)wb + WO_RO), 0, scr, r, lane); continue; } r -= 512;
            if (r < 512) { transpose_item(ARGIN(20) + (size_t)l * DM * DM, DM, DM, (bf16*)((unsigned char*)wb + WO_MIX), 0, scr, r, lane); continue; } r -= 512;
            if (r < 1024) { transpose_item(ARGIN(21) + (size_t)l * DM * 2 * DM, DM, 2 * DM, (bf16*)((unsigned char*)wb + WO_KV), 0, scr, r, lane); continue; } r -= 1024;
            if (r < 512) { transpose_item(ARGIN(22) + (size_t)l * DM * DM, DM, DM, (bf16*)((unsigned char*)wb + WO_Q), 0, scr, r, lane); continue; } r -= 512;
            if (r < 512) { transpose_item(ARGIN(23) + (size_t)l * DM * DM, DM, DM, (bf16*)((unsigned char*)wb + WO_O), 0, scr, r, lane); continue; } r -= 512;
            if (r < 2816) { transpose_item(ARGIN(24) + (size_t)l * DM * 2 * DFF, DM, 2 * DFF, (bf16*)((unsigned char*)wb + WO_FI), 2, scr, r, lane); continue; } r -= 2816;
            transpose_item(ARGIN(25) + (size_t)l * DFF * DM, DFF, DM, (bf16*)((unsigned char*)wb + WO_FO), 0, scr, r, lane);
        }
        for (int m = gw; m < MT; m += NGW) rms_row_to_bf16((m < MP) ? ARGIN(0) + (size_t)m * DM : ARGIN(1) + (size_t)(m - MP) * DM, gains, XN + (size_t)m * DM, lane);
        for (int m = gw; m < 2 * MROWS; m += NGW) { const int l = m / MROWS, rr = m - l * MROWS; rms_row_to_bf16(ARGIN(7) + (size_t)rr * DM, gains + ((size_t)l * 7 + 6) * DM, MN + (size_t)m * DM, lane); }
    }
    GRID_BAR();

#endif
#if (PHM >> 1) & 1
    for (int l = 0; l < DEPTH; ++l) {
        const bf16* wkv = (const bf16*)(ws + WS_W + (size_t)l * W_LAYER + WO_KV);
        pg8::Gemm g{MN + (size_t)l * MROWS * DM, wkv, MROWS, 2 * DM, DM}; pg8::StaticOrder S; const int cmk = bx - 96 - 64 * l;
        S.init(MROWS, 2 * DM, G, (G == 256) ? ((cmk >= 0 && cmk < 64) ? cmk : (1 << 20)) : bx);
        pg8::EpiMemKV E{out + OFF_PK + (size_t)l * MROWS * DM, out + OFF_PV + (size_t)l * MROWS * DM, MKB + (size_t)l * MROWS * DM, MVT + (size_t)l * MROWS * DM};
        pg8::gemm_phase<pg8::EpiMemKV, pg8::StaticOrder, true, true>(lds, g, S, E);
    }
#endif

    for (int l = 0; l < DEPTH; ++l) {
#define wl ((const unsigned char*)(ws + WS_W + (size_t)l * W_LAYER))
#define gl (gains + (size_t)l * 7 * DM)
#define MAKE_L() LayerIn L; L.sca = ARGIN(2) + (size_t)l * DB * 2 * DM; L.scb = ARGIN(3) + (size_t)l * DB * 3 * DM; L.sh = ARGIN(4) + (size_t)l * DB * DM; \
        L.caw = ARGIN(10) + (size_t)l * 3 * DM; L.cbw = ARGIN(12) + (size_t)l * 4 * DM; L.cbb = ARGIN(13) + (size_t)l * DM; \
        L.wga = ARGIN(14) + (size_t)l * 16 * 64 * 64; L.bga = ARGIN(15) + (size_t)l * DM; L.wgx = ARGIN(16) + (size_t)l * 16 * 64 * 64; L.bgx = ARGIN(17) + (size_t)l * DM; L.lam = ARGIN(18) + (size_t)l * DM
#if (PHM >> 2) & 1
        { pg8::Gemm g{XN, (const bf16*)(wl + WO_IN), MT, DIN, DM}; pg8::StaticOrder S; S.init(MT, DIN, G, bx); pg8::EpiInProj E{PROJ, SLOT};
          pg8::gemm_phase<pg8::EpiInProj, pg8::StaticOrder, true, true>(lds, g, S, E); }
        GRID_BAR();
#endif
#if (PHM >> 3) & 1
        for (int rs_ = 0; rs_ < REP_SCAN; ++rs_) { MAKE_L();
          ConvA CV{PROJ, PROJ + SLOT, CA, out + OFF_PCA + (size_t)l * 8 * 2 * DM, out + OFF_SA + (size_t)l * DB * 2 * DM};
          int cv_it = vcu * 512 + tid; asm volatile("" : "+v"(cv_it)); const int cv_stride = G * 512;
          for (int u = vcu; u < 512; u += G) { const int kind = u >> 8, uu = u & 255;
              scan_unit(lds, PROJ + 2 * SLOT, HS, L, out + OFF_PCB + (size_t)l * 8 * 3 * DM, out + OFF_PH + (size_t)l * 8 * DM, out + OFF_SB + (size_t)l * DB * 3 * DM, out + OFF_SH + (size_t)l * DB * DM, kind, uu >> 5, uu & 31, CV, cv_it, cv_stride); }
          for (; cv_it < MT * 128; cv_it += cv_stride) conva_item(CV, L, cv_it); }
        GRID_BAR();
#endif
#if (PHM >> 4) & 1
        { pg8::Gemm g{CA, (const bf16*)(wl + WO_CO), MP, DM, DM}; pg8::StaticOrder S; S.init(MP, DM, G, bx); pg8::EpiBf<1> E{YC, PROJ + 3 * SLOT, nullptr, DM};
          pg8::gemm_phase<pg8::EpiBf<1>, pg8::StaticOrder, true, true>(lds, g, S, E);
          }
        asm volatile("s_waitcnt vmcnt(0)" ::: "memory"); __syncthreads();
#endif
#if (PHM >> 5) & 1
        { pg8::Gemm g{HS, (const bf16*)(wl + WO_RO), MP, DM, DM}; pg8::StaticOrder S; S.init(MP, DM, G, bx); pg8::EpiBf<2> E{Z, PROJ + 4 * SLOT, YC, DM};
          pg8::gemm_phase<pg8::EpiBf<2>, pg8::StaticOrder, true, true>(lds, g, S, E);
          mini_gemm_dual(lds, CA, (const bf16*)(wl + WO_CO), HS, (const bf16*)(wl + WO_RO), PROJ + 3 * SLOT, PROJ + 4 * SLOT, Z, MP, MS, vcu, G); }
        GRID_BAR();
#endif
#if (PHM >> 6) & 1
        { pg8::Gemm g{Z, (const bf16*)(wl + WO_MIX), MP, DM, DM}; pg8::StaticOrder S; S.init(MP, DM, G, bx); pg8::EpiBf<0> E{T, nullptr, nullptr, DM};
          pg8::gemm_phase<pg8::EpiBf<0>, pg8::StaticOrder, true, true>(lds, g, S, E);
          for (int rm_ = 0; rm_ < REP_MINI; ++rm_) mini_gemm<4>(lds, Z, (const bf16*)(wl + WO_MIX), DM, DM, MP, MS, E, vcu, G); }
        GRID_BAR();
#endif
#if (PHM >> 7) & 1
        if (l == 0) row_phase<false, true>(T, ARGIN(0), ARGIN(1), X, gl + 1 * DM, gl + 2 * DM, XN, gw, NGW, lane);
        else row_phase<true, true>(T, X, nullptr, X, gl + 1 * DM, gl + 2 * DM, XN, gw, NGW, lane);
        GRID_BAR();
#endif
#if (PHM >> 8) & 1
        { pg8::Gemm g{XN, (const bf16*)(wl + WO_Q), MP, DM, DM}; pg8::StaticOrder S; S.init(MP, DM, G, bx); pg8::EpiBf<0> E{Qb, nullptr, nullptr, DM};
          pg8::gemm_phase<pg8::EpiBf<0>, pg8::StaticOrder, true, true>(lds, g, S, E);
          for (int rm_ = 0; rm_ < REP_MINI; ++rm_) mini_gemm<4>(lds, XN, (const bf16*)(wl + WO_Q), DM, DM, MP, MS, E, vcu, G); }
        GRID_BAR();
#endif
#if (PHM >> 9) & 1
        for (int ra_ = 0; ra_ < REP_ATTN; ++ra_) {
          const bool sample_first = (vcu & 1) != 0;
          for (int ph = 0; ph < 2; ++ph) {
            if ((ph == 0) != sample_first) { for (int u = vcu; u < 512; u += G) attn_prompt_unit(lds, Qb, MKB + (size_t)l * MROWS * DM, MVT + (size_t)l * MROWS * DM, Ob, u >> 6, (u >> 4) & 3, u & 15); }
            else { const float* ck = ARGIN(5) + (size_t)l * DB * NMEM * DM; const float* cv = ARGIN(6) + (size_t)l * DB * NMEM * DM;
              for (int rs2_ = 0; rs2_ < REP_ATTS; ++rs2_) attn_sample_units(lds, Qb, ck, cv, Ob, vcu, G); }
          } }
        GRID_BAR();
#endif
#if (PHM >> 10) & 1
        { pg8::Gemm g{Ob, (const bf16*)(wl + WO_O), MP, DM, DM}; pg8::StaticOrder S; S.init(MP, DM, G, bx); pg8::EpiBf<0> E{T, nullptr, nullptr, DM};
          pg8::gemm_phase<pg8::EpiBf<0>, pg8::StaticOrder, true, true>(lds, g, S, E);
          for (int rm_ = 0; rm_ < REP_MINI; ++rm_) mini_gemm<4>(lds, Ob, (const bf16*)(wl + WO_O), DM, DM, MP, MS, E, vcu, G); }
        GRID_BAR();
#endif
#if (PHM >> 11) & 1
        row_phase<true, true>(T, X, nullptr, X, gl + 3 * DM, gl + 4 * DM, XN, gw, NGW, lane);
        GRID_BAR();
#endif
#if (PHM >> 12) & 1
        { pg8::Gemm g{XN, (const bf16*)(wl + WO_FI), MT, 2 * DFF, DM}; pg8::StaticOrder S; S.init(MT, 2 * DFF, G, bx); pg8::EpiSwiGLU E{ACT, DFF};
          pg8::gemm_phase<pg8::EpiSwiGLU, pg8::StaticOrder, true, true>(lds, g, S, E); }
        GRID_BAR();
#endif
#if (PHM >> 13) & 1
        { pg8::Gemm g{ACT, (const bf16*)(wl + WO_FO), MP, DM, DFF}; pg8::StaticOrder S; S.init(MP, DM, G, bx); pg8::EpiBf<0> E{T, nullptr, nullptr, DM};
          pg8::gemm_phase<pg8::EpiBf<0>, pg8::StaticOrder, true, true>(lds, g, S, E);
          for (int rm_ = 0; rm_ < REP_MINI; ++rm_) mini_gemm<11>(lds, ACT, (const bf16*)(wl + WO_FO), DFF, DM, MP, MS, E, vcu, G); }
        GRID_BAR();
#endif
#if (PHM >> 14) & 1
        if (l == DEPTH - 1) row_phase<true, false>(T, X, nullptr, out + OFF_Y, gl + 5 * DM, nullptr, nullptr, gw, NGW, lane);
        else row_phase<true, true>(T, X, nullptr, X, gl + 5 * DM, gains + (size_t)(l + 1) * 7 * DM, XN, gw, NGW, lane);
#endif
        if (l != DEPTH - 1) GRID_BAR();
    }
    if (G == 0x7ffffff0) cg::this_grid().sync();
}

#undef tid
#undef lane
#undef wave
#undef G
#undef bx
#undef vcu
#undef gw
#undef NGW
#undef ws
#undef out
#undef XN
#undef MN
#undef PROJ
#undef CA
#undef HS
#undef YC
#undef Z
#undef T
#undef X
#undef Qb
#undef Ob
#undef ACT
#undef MKB
#undef MVT
#undef gains
#undef wl
#undef gl
extern "C" void kernel_launch(void* const* d_in, const int* in_sizes, int n_in, void* d_out, int out_size, void* d_ws, size_t ws_size, hipStream_t stream) {
    static int grid = 0;
    if (grid == 0) {
        if (n_in != 26 || (size_t)out_size != OUT_TOTAL || ws_size < WS_END) { fprintf(stderr, "kernel_launch: unexpected shapes: n_in %d out %d ws %zu\n", n_in, out_size, ws_size); grid = -1; return; }
        int dev = 0, cus = 0, per_cu = 0;
        if (hipGetDevice(&dev) != hipSuccess || hipDeviceGetAttribute(&cus, hipDeviceAttributeMultiprocessorCount, dev) != hipSuccess) { grid = -1; return; }
        if (hipFuncSetAttribute((const void*)fwd_megakernel, hipFuncAttributeMaxDynamicSharedMemorySize, LDS_BYTES) != hipSuccess) { fprintf(stderr, "kernel_launch: hipFuncSetAttribute failed\n"); grid = -1; return; }
        if (hipOccupancyMaxActiveBlocksPerMultiprocessor(&per_cu, (const void*)fwd_megakernel, NWAVES * 64, LDS_BYTES) != hipSuccess || per_cu < 1) { fprintf(stderr, "kernel_launch: occupancy query says %d\n", per_cu); per_cu = 1; }
        (void)hipGetLastError();
        grid = cus;
    }
    if (grid < 0) return;
    (void)hipMemsetAsync((char*)d_ws + WS_CTL, 0, CTL_ZERO_BYTES, stream);
    Args a{};
    for (int i = 0; i < 26; ++i) a.in[i] = (const float*)d_in[i];
    a.out = (float*)d_out; a.ws = (unsigned char*)d_ws;
    void* kargs[] = {&a};
    hipError_t e = hipLaunchCooperativeKernel((const void*)fwd_megakernel, dim3(grid), dim3(NWAVES * 64), kargs, LDS_BYTES, stream);
    if (e != hipSuccess) fprintf(stderr, "kernel_launch: cooperative launch failed: %s (grid %d)\n", hipGetErrorString(e), grid);
}
```

```cpp
#include <hip/hip_runtime.h>
#include <hip/hip_cooperative_groups.h>
#include <cstdio>
#include <cstdint>
namespace cg = cooperative_groups;
#ifndef PHM
#define PHM 0xFFFFFF
#endif
#define CONVA_INTERLEAVE 1
#define REP_S1 1
#define REP_S2 1
#define REP_S3 1
#define REP_PRO 1
#define REP_ATTS 1
#define REP_ROW 1
#define REP_SCAN 1
#define REP_ATTN 1
#define REP_BAR 1
#define REP_MINI 1
namespace pg8 {
#define PG8_LAS __attribute__((address_space(3)))
typedef unsigned short bf16_t;
typedef short bf16x8 __attribute__((ext_vector_type(8)));
typedef float f32x4 __attribute__((ext_vector_type(4)));
typedef unsigned u32x4 __attribute__((ext_vector_type(4)));
constexpr int BM = 256, BK = 64, HALF = 128, HTB = HALF * BK * 2  , STAGE_BYTES = 8 * HTB, NXCD = 8, WGM = 8;

__host__ __device__ __forceinline__ int lds_byte(int r, int c) { const int st = (r >> 4) * 2 + (c >> 5), rr = r & 15, cc = c & 31, ob = rr * 64 + cc * 2; return st * 1024 + (ob ^ (((ob >> 9) & 1) << 5)); }
__host__ __device__ __forceinline__ void stage_rc(int b, int& R, int& C) { const int st = b / 1024, sb = b % 1024, swz = sb ^ (((sb >> 9) & 1) << 5); R = (st >> 1) * 16 + swz / 64; C = (st & 1) * 32 + (swz % 64) / 2; }
__host__ __device__ __forceinline__ int perm32(int rho) { const int n = rho >> 4, i = rho & 15; return 8 * (i >> 2) + 4 * n + (i & 3); }

struct Unit { int pm, pn; };
struct Gemm { const bf16_t* A; const bf16_t* Bt; int M, N, K; };

struct StaticOrder {
    int nM, nN, nwg, G, c;
    __host__ __device__ void init(int M, int N, int G_, int c_) { nM = M / BM; nN = N / BM; nwg = nM * nN; G = G_; c = c_; }
    __host__ __device__ bool next(int i, Unit& u) const {
        const long L = (long)i * G + c; if (L >= nwg) return false;
        int wgid = (int)L; { const int q = nwg / NXCD, r = nwg % NXCD, xcd = wgid % NXCD, off = wgid / NXCD; wgid = (xcd < r ? xcd * (q + 1) : r * (q + 1) + (xcd - r) * q) + off; }
        const int nig = WGM * nN, gid = wgid / nig, fm = gid * WGM, gsz = (nM - fm) < WGM ? (nM - fm) : WGM;
        u.pm = fm + ((wgid % nig) % gsz); u.pn = (wgid % nig) / gsz; return true;
    }
    __device__ __forceinline__ void a_ready(const Unit&) const {}
    __device__ __forceinline__ void done(const Unit&) const {}
};

typedef float f32x2_t __attribute__((ext_vector_type(2))); typedef __bf16 bf16x2_t __attribute__((ext_vector_type(2)));
__device__ __forceinline__ unsigned cvt_pk_bf16(float lo, float hi) { f32x2_t v = {lo, hi}; bf16x2_t b = __builtin_convertvector(v, bf16x2_t); return __builtin_bit_cast(unsigned, b); }
typedef unsigned u32x2 __attribute__((ext_vector_type(2)));
__device__ __forceinline__ float bflo(unsigned w) { return __uint_as_float(w << 16); }
__device__ __forceinline__ float bfhi(unsigned w) { return __uint_as_float(w & 0xffff0000u); }
__device__ __forceinline__ float sigmoidf_(float x) { return __builtin_amdgcn_rcpf(1.0f + __expf(-x)); }
__device__ __forceinline__ void st_bf16x4(bf16_t* p, f32x4 v) { u32x2 w; w.x = cvt_pk_bf16(v[0], v[1]); w.y = cvt_pk_bf16(v[2], v[3]); *(u32x2*)p = w; }
__device__ __forceinline__ f32x4 ld_bf16x4(const bf16_t* p) { const u32x2 w = *(const u32x2*)p; return (f32x4){bflo(w.x), bfhi(w.x), bflo(w.y), bfhi(w.y)}; }

typedef unsigned u32x4e __attribute__((ext_vector_type(4)));
__device__ __forceinline__ void st_bf16x8(bf16_t* p, f32x4 a, f32x4 b) { u32x4e w; w.x = cvt_pk_bf16(a[0], a[1]); w.y = cvt_pk_bf16(a[2], a[3]); w.z = cvt_pk_bf16(b[0], b[1]); w.w = cvt_pk_bf16(b[2], b[3]); *(u32x4e*)p = w; }
__device__ __forceinline__ void ld_bf16x8(const bf16_t* p, f32x4& a, f32x4& b) { const u32x4e w = *(const u32x4e*)p; a = (f32x4){bflo(w.x), bfhi(w.x), bflo(w.y), bfhi(w.y)}; b = (f32x4){bflo(w.z), bfhi(w.z), bflo(w.w), bfhi(w.w)}; }
template <int MODE> struct EpiBf {
    static constexpr bool PERM = true, AFTER_DRAIN = false;
    bf16_t* O; const bf16_t* mul; const bf16_t* add; int ldc;
    __device__ __forceinline__ void apply(int row, int col, f32x4 v) const { const size_t o = (size_t)row * ldc + col;
        if (MODE >= 1) v = v * ld_bf16x4(mul + o);
        if (MODE == 2) v = v + ld_bf16x4(add + o);
        st_bf16x4(O + o, v); }
    __device__ __forceinline__ void operator()(const f32x4 (&acc)[2][2][4][2], const Unit& u, int wr, int wc, int fr, int fq) const {
        const int row0 = u.pm * BM + wr * 64 + fr, col0 = u.pn * BM + wc * 32 + 8 * fq;
#pragma unroll
        for (int ai = 0; ai < 2; ++ai) {
            u32x4e gm[4][2], ga[4][2];
            if (MODE >= 1) {
#pragma unroll
                for (int m = 0; m < 4; ++m)
#pragma unroll
                    for (int bj = 0; bj < 2; ++bj) { const size_t o = (size_t)(row0 + ai * HALF + m * 16) * ldc + col0 + bj * HALF; gm[m][bj] = __builtin_nontemporal_load((const u32x4e*)(mul + o)); if (MODE == 2) ga[m][bj] = __builtin_nontemporal_load((const u32x4e*)(add + o)); } }
#pragma unroll
            for (int m = 0; m < 4; ++m) { const size_t ro = (size_t)(row0 + ai * HALF + m * 16) * ldc + col0;
#pragma unroll
                for (int bj = 0; bj < 2; ++bj) { const size_t o = ro + bj * HALF; f32x4 v0 = acc[ai][bj][m][0], v1 = acc[ai][bj][m][1];
                        if (MODE >= 1) { const u32x4e w = gm[m][bj]; v0 = v0 * (f32x4){bflo(w.x), bfhi(w.x), bflo(w.y), bfhi(w.y)}; v1 = v1 * (f32x4){bflo(w.z), bfhi(w.z), bflo(w.w), bfhi(w.w)}; }
                        if (MODE == 2) { const u32x4e w = ga[m][bj]; v0 = v0 + (f32x4){bflo(w.x), bfhi(w.x), bflo(w.y), bfhi(w.y)}; v1 = v1 + (f32x4){bflo(w.z), bfhi(w.z), bflo(w.w), bfhi(w.w)}; }
                        st_bf16x8(O + o, v0, v1); } }
            if (MODE >= 1) asm volatile("" ::: "memory"); }
    }
};
struct EpiF32 {
    static constexpr bool PERM = false, AFTER_DRAIN = false;
    float* O; int ldc;
    __device__ __forceinline__ void apply(int row, int col, f32x4 v) const { *(f32x4*)(O + (size_t)row * ldc + col) = v; }
    __device__ __forceinline__ void operator()(const f32x4 (&acc)[2][2][4][2], const Unit& u, int wr, int wc, int fr, int fq) const {
        const int row0 = u.pm * BM + wr * 64 + fr, col0 = u.pn * BM + wc * 32 + 4 * fq;
#pragma unroll
        for (int ai = 0; ai < 2; ++ai)
#pragma unroll
            for (int m = 0; m < 4; ++m) { const size_t ro = (size_t)(row0 + ai * HALF + m * 16) * ldc + col0;
#pragma unroll
                for (int bj = 0; bj < 2; ++bj)
#pragma unroll
                    for (int n = 0; n < 2; ++n) *(f32x4*)(O + ro + bj * HALF + n * 16) = acc[ai][bj][m][n]; }
    }
};
struct EpiInProj {
    static constexpr bool PERM = true, AFTER_DRAIN = false;
    bf16_t* P; size_t slot;
    __device__ __forceinline__ void operator()(const f32x4 (&acc)[2][2][4][2], const Unit& u, int wr, int wc, int fr, int fq) const {
        const int row0 = u.pm * BM + wr * 64 + fr; const int pn = u.pn;
        if (pn >= 4 && pn < 12) {
            bf16_t* base = P + slot; const int col0 = (pn - 4) * HALF + wc * 32 + 8 * fq;
#pragma unroll
            for (int ai = 0; ai < 2; ++ai)
#pragma unroll
                for (int m = 0; m < 4; ++m) { const size_t ro = (size_t)(row0 + ai * HALF + m * 16) * 1024 + col0;
                    st_bf16x8(base + ro, acc[ai][0][m][0] * acc[ai][1][m][0], acc[ai][0][m][1] * acc[ai][1][m][1]); }
        } else {
            int s, ct; if (pn < 4) { s = 0; ct = pn; } else if (pn < 16) { s = 2; ct = pn - 12; } else if (pn < 20) { s = 3; ct = pn - 16; } else { s = 4; ct = pn - 20; }
            bf16_t* base = P + (size_t)s * slot; const int col0 = ct * BM + wc * 32 + 8 * fq; const bool sg = (s >= 3);
#pragma unroll
            for (int ai = 0; ai < 2; ++ai)
#pragma unroll
                for (int m = 0; m < 4; ++m) { const size_t ro = (size_t)(row0 + ai * HALF + m * 16) * 1024 + col0;
#pragma unroll
                    for (int bj = 0; bj < 2; ++bj) { f32x4 v0 = acc[ai][bj][m][0], v1 = acc[ai][bj][m][1];
                            if (sg) {
#pragma unroll
                                for (int i = 0; i < 4; ++i) { v0[i] = sigmoidf_(v0[i]); v1[i] = sigmoidf_(v1[i]); } }
                            st_bf16x8(base + ro + bj * HALF, v0, v1); } }
        }
    }
};
struct EpiSwiGLU {
    static constexpr bool PERM = true, AFTER_DRAIN = false;
    bf16_t* O; int ldc;
    __device__ __forceinline__ void operator()(const f32x4 (&acc)[2][2][4][2], const Unit& u, int wr, int wc, int fr, int fq) const {
        const int row0 = u.pm * BM + wr * 64 + fr, col0 = u.pn * HALF + wc * 32 + 8 * fq;
#pragma unroll
        for (int ai = 0; ai < 2; ++ai)
#pragma unroll
            for (int m = 0; m < 4; ++m) { const size_t ro = (size_t)(row0 + ai * HALF + m * 16) * ldc + col0; f32x4 v[2];
#pragma unroll
                for (int n = 0; n < 2; ++n) { const f32x4 g = acc[ai][0][m][n], up = acc[ai][1][m][n];
#pragma unroll
                    for (int i = 0; i < 4; ++i) v[n][i] = g[i] * sigmoidf_(g[i]) * up[i]; }
                st_bf16x8(O + ro, v[0], v[1]); }
    }
};
struct EpiMemKV {
    static constexpr bool PERM = false, AFTER_DRAIN = false;
    float* outK; float* outV; bf16_t* KB; bf16_t* VT;
    __device__ __forceinline__ void operator()(const f32x4 (&acc)[2][2][4][2], const Unit& u, int wr, int wc, int fr, int fq) const {
        const int row0 = u.pm * BM + wr * 64 + fr; const bool isv = (u.pn >= 4); const int col0 = (u.pn & 3) * BM + wc * 32 + 4 * fq;
        float* of = isv ? outV : outK;
#pragma unroll
        for (int ai = 0; ai < 2; ++ai)
#pragma unroll
            for (int m = 0; m < 4; ++m) { const int row = row0 + ai * HALF + m * 16; const size_t ro = (size_t)row * 1024 + col0;
#pragma unroll
                for (int bj = 0; bj < 2; ++bj)
#pragma unroll
                    for (int n = 0; n < 2; ++n) { const f32x4 v = acc[ai][bj][m][n]; const size_t o = ro + bj * HALF + n * 16;
                        __builtin_nontemporal_store(v, (f32x4*)(of + o));
                        if (!isv) st_bf16x4(KB + o, v);
                        else { const int c = col0 + bj * HALF + n * 16; const int b = row >> 8, mm = row & 255;
                            bf16_t* vt = VT + ((size_t)(b * 1024 + c)) * 256 + mm;
                            const unsigned w0 = cvt_pk_bf16(v[0], v[1]), w1 = cvt_pk_bf16(v[2], v[3]);
                            vt[0] = (bf16_t)(w0 & 0xffffu); vt[256] = (bf16_t)(w0 >> 16); vt[512] = (bf16_t)(w1 & 0xffffu); vt[768] = (bf16_t)(w1 >> 16); } } }
    }
};

template <class Epi, class Sched, bool ALIGN_EPI = false, bool SP2 = false>
__device__ __forceinline__ void gemm_phase(PG8_LAS unsigned char* lds, const Gemm g, const Sched& S, const Epi& E) {
    int tid_o = threadIdx.x; asm volatile("" : "+v"(tid_o));
    const int tid = tid_o, wid = __builtin_amdgcn_readfirstlane(tid >> 6), lane = tid & 63, wr = wid >> 2, wc = wid & 3, fr = lane & 15, fq = lane >> 4;
    const int K = g.K, nt = K / BK;
    unsigned voffA[2], voffB[2];
#pragma unroll
    for (int i = 0; i < 2; ++i) { int R, C; stage_rc(tid * 16 + i * 8192, R, C); const int Rb = Epi::PERM ? ((R & ~31) + perm32(R & 31)) : R;
        voffA[i] = (unsigned)(R * K + C) * 2u; voffB[i] = (unsigned)(Rb * K + C) * 2u; }
    const size_t kstep = (size_t)(BK * 2);
    const size_t hstep = (size_t)HALF * K * 2;
    const size_t tstep = 2 * hstep;
    const unsigned ldsw = (unsigned)wid * 1024u;
    const int aoff = lds_byte(wr * 64 + fr, fq * 8), boff = lds_byte(wc * 32 + fr, fq * 8);
#define PG8_SA(b, h) (((b) * 2 + (h)) * HTB)
#define PG8_SB(b, h) ((4 + (b) * 2 + (h)) * HTB)
#define PG8_STAGE(bufoff, gbase, voff) do { _Pragma("unroll") for (int _i = 0; _i < 2; ++_i) \
        __builtin_amdgcn_global_load_lds((const unsigned*)((const char*)(gbase) + (voff)[_i]), (PG8_LAS unsigned*)(lds + (bufoff) + ldsw + _i * 8192), 16, 0, 0); } while (0)
#define PG8_LDA(dst, b, h) do { _Pragma("unroll") for (int m = 0; m < 4; ++m) _Pragma("unroll") for (int k = 0; k < 2; ++k) dst[m][k] = *(const PG8_LAS bf16x8*)(lds + PG8_SA(b, h) + aoff + m * 2048 + k * 1024); } while (0)
#define PG8_LDB(dst, b, h) do { _Pragma("unroll") for (int n = 0; n < 2; ++n) _Pragma("unroll") for (int k = 0; k < 2; ++k) dst[n][k] = *(const PG8_LAS bf16x8*)(lds + PG8_SB(b, h) + boff + n * 2048 + k * 1024); } while (0)
#define PG8_MMA(ai, bj, At, Bt) do { __builtin_amdgcn_s_setprio(1); _Pragma("unroll") for (int m = 0; m < 4; ++m) _Pragma("unroll") for (int n = 0; n < 2; ++n) _Pragma("unroll") for (int k = 0; k < 2; ++k) \
        acc[ai][bj][m][n] = __builtin_amdgcn_mfma_f32_16x16x32_bf16(Bt[n][k], At[m][k], acc[ai][bj][m][n], 0, 0, 0); __builtin_amdgcn_s_setprio(0); } while (0)
#define PG8_WAIT_V(n) asm volatile("s_waitcnt vmcnt(" #n ")" ::: "memory")
#define PG8_WAIT_L(n) asm volatile("s_waitcnt lgkmcnt(" #n ")" ::: "memory")
#define PG8_BAR __builtin_amdgcn_s_barrier()
#define PG8_SCHED __builtin_amdgcn_sched_barrier(0)
    Unit cur, nxt; int ui = 0;
    if (!S.next(0, cur)) return;
    f32x4 acc[2][2][4][2];
#pragma unroll
    for (int a = 0; a < 2; ++a)
#pragma unroll
        for (int b = 0; b < 2; ++b)
#pragma unroll
            for (int m = 0; m < 4; ++m)
#pragma unroll
                for (int n = 0; n < 2; ++n) acc[a][b][m][n] = (f32x4){0.f, 0.f, 0.f, 0.f};
    bf16x8 At[4][2], B0[2][2], B1[2][2];
    const char* cA = (const char*)g.A + (size_t)cur.pm * tstep; const char* cB = (const char*)g.Bt + (size_t)cur.pn * tstep;
    S.a_ready(cur);
    if constexpr (SP2) {
        PG8_STAGE(PG8_SB(0, 0), cB, voffB); PG8_STAGE(PG8_SB(0, 1), cB + hstep, voffB); PG8_STAGE(PG8_SA(0, 0), cA, voffA); PG8_STAGE(PG8_SA(0, 1), cA + hstep, voffA);
        if (wr == 1) PG8_BAR;
        PG8_WAIT_V(2); PG8_BAR;
        PG8_STAGE(PG8_SB(1, 0), cB + kstep, voffB); PG8_STAGE(PG8_SA(1, 0), cA + kstep, voffA); PG8_STAGE(PG8_SB(1, 1), cB + hstep + kstep, voffB);
        PG8_WAIT_V(6); PG8_BAR;
    } else {
        PG8_STAGE(PG8_SB(0, 0), cB, voffB); PG8_STAGE(PG8_SA(0, 0), cA, voffA); PG8_STAGE(PG8_SB(0, 1), cB + hstep, voffB); PG8_STAGE(PG8_SA(0, 1), cA + hstep, voffA);
        if (wr == 1) PG8_BAR;
        PG8_WAIT_V(4); PG8_BAR;
        PG8_STAGE(PG8_SB(1, 0), cB + kstep, voffB); PG8_STAGE(PG8_SA(1, 0), cA + kstep, voffA); PG8_STAGE(PG8_SB(1, 1), cB + hstep + kstep, voffB);
        PG8_WAIT_V(6); PG8_BAR;
    }
    for (;;) {
        const bool has_next = S.next(ui + 1, nxt);
        const char* nA = has_next ? (const char*)g.A + (size_t)nxt.pm * tstep : cA; const char* nB = has_next ? (const char*)g.Bt + (size_t)nxt.pn * tstep : cB;
        for (int t = 0; t < nt; t += 2) {
            const bool last = (t == nt - 2);
            const char* a1 = cA + (size_t)(t + 1) * kstep;
            const char* a2 = last ? nA : cA + (size_t)(t + 2) * kstep; const char* b2 = last ? nB : cB + (size_t)(t + 2) * kstep;
            const char* a3 = a2 + kstep; const char* b3 = b2 + kstep;
            if (last && has_next) S.a_ready(nxt);
            if constexpr (SP2) {
            PG8_LDB(B0, 0, 0); PG8_LDB(B1, 0, 1); PG8_SCHED; PG8_LDA(At, 0, 0); PG8_STAGE(PG8_SA(1, 1), a1 + hstep, voffA);
            PG8_WAIT_V(8); PG8_WAIT_L(0); PG8_BAR; PG8_MMA(0, 0, At, B0); PG8_MMA(0, 1, At, B1); PG8_BAR; PG8_SCHED;
            PG8_LDA(At, 0, 1); PG8_STAGE(PG8_SB(0, 0), b2, voffB); PG8_STAGE(PG8_SB(0, 1), b2 + hstep, voffB); PG8_STAGE(PG8_SA(0, 0), a2, voffA);
            PG8_WAIT_V(8); PG8_WAIT_L(0); PG8_BAR; PG8_MMA(1, 0, At, B0); PG8_MMA(1, 1, At, B1); PG8_BAR; PG8_SCHED;
            PG8_LDB(B0, 1, 0); PG8_LDB(B1, 1, 1); PG8_SCHED; PG8_LDA(At, 1, 0); PG8_STAGE(PG8_SA(0, 1), a2 + hstep, voffA);
            PG8_WAIT_V(8); PG8_WAIT_L(0); PG8_BAR; PG8_MMA(0, 0, At, B0); PG8_MMA(0, 1, At, B1); PG8_BAR; PG8_SCHED;
            PG8_LDA(At, 1, 1); PG8_STAGE(PG8_SB(1, 0), b3, voffB); PG8_STAGE(PG8_SB(1, 1), b3 + hstep, voffB); PG8_STAGE(PG8_SA(1, 0), a3, voffA);
            PG8_WAIT_V(8); PG8_WAIT_L(0); PG8_BAR; PG8_MMA(1, 0, At, B0); PG8_MMA(1, 1, At, B1); PG8_BAR; PG8_SCHED;
            } else {
            PG8_LDB(B0, 0, 0); PG8_SCHED; PG8_LDA(At, 0, 0); PG8_STAGE(PG8_SA(1, 1), a1 + hstep, voffA);
            PG8_WAIT_L(8); PG8_BAR; PG8_WAIT_L(0); PG8_MMA(0, 0, At, B0); PG8_BAR; PG8_SCHED;
            PG8_LDB(B1, 0, 1); PG8_STAGE(PG8_SB(0, 0), b2, voffB);
            PG8_BAR; PG8_WAIT_L(0); PG8_MMA(0, 1, At, B1); PG8_BAR;
            PG8_LDA(At, 0, 1); PG8_STAGE(PG8_SA(0, 0), a2, voffA);
            PG8_BAR; PG8_WAIT_L(0); PG8_MMA(1, 0, At, B0); PG8_BAR; PG8_SCHED;
            PG8_STAGE(PG8_SB(0, 1), b2 + hstep, voffB);
            PG8_WAIT_V(6); PG8_BAR; PG8_MMA(1, 1, At, B1); PG8_BAR;
            PG8_LDB(B0, 1, 0); PG8_SCHED; PG8_LDA(At, 1, 0); PG8_STAGE(PG8_SA(0, 1), a2 + hstep, voffA);
            PG8_WAIT_L(8); PG8_BAR; PG8_WAIT_L(0); PG8_MMA(0, 0, At, B0); PG8_BAR; PG8_SCHED;
            PG8_LDB(B1, 1, 1); PG8_STAGE(PG8_SB(1, 0), b3, voffB);
            PG8_BAR; PG8_WAIT_L(0); PG8_MMA(0, 1, At, B1); PG8_BAR;
            PG8_LDA(At, 1, 1); PG8_STAGE(PG8_SA(1, 0), a3, voffA);
            PG8_BAR; PG8_WAIT_L(0); PG8_MMA(1, 0, At, B0); PG8_BAR; PG8_SCHED;
            PG8_STAGE(PG8_SB(1, 1), b3 + hstep, voffB);
            PG8_WAIT_V(6); PG8_BAR; PG8_MMA(1, 1, At, B1); PG8_BAR;
            }
        }
        if constexpr (ALIGN_EPI) { if (wr == 0) PG8_BAR; }
        if constexpr (!Epi::AFTER_DRAIN) { E(acc, cur, wr, wc, fr, fq); S.done(cur); }
        if (!has_next) break;
#pragma unroll
        for (int a = 0; a < 2; ++a)
#pragma unroll
            for (int b = 0; b < 2; ++b)
#pragma unroll
                for (int m = 0; m < 4; ++m)
#pragma unroll
                    for (int n = 0; n < 2; ++n) acc[a][b][m][n] = (f32x4){0.f, 0.f, 0.f, 0.f};
        cur = nxt; cA = nA; cB = nB; ++ui;
        if constexpr (ALIGN_EPI) { if (wr == 1) PG8_BAR; }
    }
    PG8_WAIT_V(0);
    if constexpr (!ALIGN_EPI) { if (wr == 0) PG8_BAR; }
    PG8_BAR;
    if constexpr (Epi::AFTER_DRAIN) { E.fused(acc, cur, wr, wc, fr, fq, lds, wid, lane); S.done(cur); }
#undef PG8_SA
#undef PG8_SB
#undef PG8_STAGE
#undef PG8_LDA
#undef PG8_LDB
#undef PG8_MMA
#undef PG8_WAIT_V
#undef PG8_WAIT_L
#undef PG8_BAR
#undef PG8_SCHED
}
}

constexpr int NWAVES = 8;
constexpr int DM = 1024, NB = 8, SEQ = 2048, DEPTH = 2, DB = 128, DSEQ = 8, NMEM = 256, NH = 4, HD = 256, DFF = 2816, DIN = 6144;
constexpr int MP = NB * SEQ, MS = DB * DSEQ, MT = MP + MS;
constexpr int MROWS = NB * NMEM;
constexpr float EPS = 1e-6f;
constexpr size_t MiB = 1u << 20;
constexpr size_t WS_CTL = 0, CTL_ZERO_BYTES = 64 * 1024;
constexpr size_t WS_W = 2 * MiB, W_LAYER = 44 * MiB;
constexpr size_t WO_IN = 0, WO_CO = 12 * MiB, WO_RO = 14 * MiB, WO_MIX = 16 * MiB, WO_KV = 18 * MiB, WO_Q = 22 * MiB, WO_O = 24 * MiB, WO_FI = 26 * MiB, WO_FO = 37 * MiB;
constexpr size_t WS_XN = 92 * MiB;
constexpr size_t WS_MN = 128 * MiB;
constexpr size_t WS_PROJ = 138 * MiB;
constexpr size_t WS_CA = 310 * MiB, WS_HS = 346 * MiB, WS_YC = 382 * MiB, WS_Z = 418 * MiB;
constexpr size_t WS_T = 454 * MiB, WS_X = 524 * MiB;
constexpr size_t WS_Q = 594 * MiB, WS_O = 630 * MiB;
constexpr size_t WS_ACT = 666 * MiB;
constexpr size_t WS_MKB = 762 * MiB, WS_MVT = 772 * MiB;
constexpr size_t WS_END = 782 * MiB;
constexpr size_t SLOT = (size_t)MT * DM;
constexpr size_t OFF_Y = 0, OFF_PCA = (size_t)MT * DM, OFF_PCB = OFF_PCA + 2 * 8 * 2 * 1024, OFF_PH = OFF_PCB + 2 * 8 * 3 * 1024, OFF_PK = OFF_PH + 2 * 8 * 1024,
                 OFF_PV = OFF_PK + (size_t)2 * MROWS * DM, OFF_SA = OFF_PV + (size_t)2 * MROWS * DM, OFF_SB = OFF_SA + 2 * 128 * 2 * 1024, OFF_SH = OFF_SB + 2 * 128 * 3 * 1024,
                 OUT_TOTAL = OFF_SH + 2 * 128 * 1024;
constexpr int CW_BAR = 1024;
constexpr int LDS_BYTES = 147456;
constexpr int MISC_OFF = 146432;

#define GAS __attribute__((address_space(1)))
#define LAS __attribute__((address_space(3)))
typedef unsigned short bf16;
typedef unsigned v4u __attribute__((ext_vector_type(4)));
typedef unsigned v2u __attribute__((ext_vector_type(2)));
typedef float f32x4 __attribute__((ext_vector_type(4)));
typedef short bf16x8 __attribute__((ext_vector_type(8)));
#define LDS_WAIT() asm volatile("s_waitcnt lgkmcnt(0)" ::: "memory")
using pg8::cvt_pk_bf16; using pg8::bflo; using pg8::bfhi; using pg8::sigmoidf_;
__device__ __forceinline__ float wave_sum(float v) {
#pragma unroll
    for (int o = 1; o < 64; o <<= 1) v += __shfl_xor(v, o);
    return v;
}
#define XB_TMO      128
#define XB_XCNT(j)  (256  + 64 * (j))
#define XB_XSUB(j)  (1280 + 64 * (j))
#define XB_XGEN(j)  (2304 + 64 * (j))
#define XB_TOP      3328
#define XB_TOPGEN   3392
#define XCD_BAR_WORDS 3456
#define XB_SPIN_CAP (1u << 18)

__device__ __forceinline__ unsigned xb_ld(unsigned* p)              { return __hip_atomic_load(p, __ATOMIC_RELAXED, __HIP_MEMORY_SCOPE_AGENT); }
__device__ __forceinline__ unsigned xb_add(unsigned* p, unsigned v) { return __hip_atomic_fetch_add(p, v, __ATOMIC_RELAXED, __HIP_MEMORY_SCOPE_AGENT); }
__device__ __forceinline__ unsigned xb_xcc_id() { return (unsigned)__builtin_amdgcn_s_getreg((3 << 11) | 20) & 0xFu; }
#define XB_SPIN(cond, bar) do { unsigned _sp = 0; while (cond) { __builtin_amdgcn_s_sleep(1); \
    if ((++_sp & 255u) == 0u) { if (xb_ld(&(bar)[XB_TMO])) break; if (_sp > XB_SPIN_CAP) { atomicAdd(&(bar)[XB_TMO], 1u); break; } } } } while (0)

struct XcdBarrier {
    unsigned* bar; unsigned x;
    volatile LAS unsigned* st;
};

__device__ __forceinline__ XcdBarrier xcd_barrier_post(unsigned* bar, volatile LAS unsigned* st) {
    XcdBarrier b; b.bar = bar; b.x = xb_xcc_id(); b.st = st;
    if (threadIdx.x == 0) (void)xb_add(&bar[XB_XCNT(b.x)], 1u);
    return b;
}
__device__ __forceinline__ void xcd_barrier_complete(unsigned* bar, unsigned x, unsigned& nloc, unsigned& nx) {
    const unsigned G = gridDim.x * gridDim.y * gridDim.z;
    unsigned sum, cnt, mine, sp = 0u;
    for (;;) {
        sum = 0u; cnt = 0u; mine = 0u;
#pragma unroll
        for (unsigned j = 0; j < 16; ++j) { const unsigned c = xb_ld(&bar[XB_XCNT(j)]); sum += c; cnt += (c > 0u) ? 1u : 0u; mine = (j == x) ? c : mine; }
        if (sum == G) break;
        __builtin_amdgcn_s_sleep(1);
        if ((++sp & 255u) == 0u) { if (xb_ld(&bar[XB_TMO])) break; if (sp > XB_SPIN_CAP) { atomicAdd(&bar[XB_TMO], 1u); break; } }
    }
    nloc = mine > 0u ? mine : 1u; nx = cnt > 0u ? cnt : 1u;
}

__device__ __forceinline__ void xcd_barrier(const XcdBarrier& b) {
    asm volatile("s_waitcnt vmcnt(0)" ::: "memory");
    __syncthreads();
    if (threadIdx.x == 0) {
        unsigned* bar = b.bar;
        __builtin_amdgcn_s_waitcnt(0);
        unsigned nloc = b.st[0], nx = b.st[1];
        if (nloc == 0u) { xcd_barrier_complete(bar, b.x, nloc, nx); b.st[0] = nloc; b.st[1] = nx; }
        const unsigned old = xb_add(&bar[XB_XSUB(b.x)], 1u);
        const unsigned gen = old / nloc;
        if (old + 1u == (gen + 1u) * nloc) {
            __builtin_amdgcn_fence(__ATOMIC_RELEASE, "agent");
            asm volatile("s_waitcnt vmcnt(0)" ::: "memory");
            const unsigned og = xb_add(&bar[XB_TOP], 1u);
            const unsigned tg = og / nx;
            if (og + 1u == (tg + 1u) * nx) xb_add(&bar[XB_TOPGEN], 1u);
            else XB_SPIN(xb_ld(&bar[XB_TOPGEN]) == tg, bar);
            __builtin_amdgcn_fence(__ATOMIC_ACQUIRE, "agent");
            xb_add(&bar[XB_XGEN(b.x)], 1u);
            asm volatile("s_waitcnt vmcnt(0)" ::: "memory");
        } else {
            XB_SPIN(xb_ld(&bar[XB_XGEN(b.x)]) == gen, bar);
            __builtin_amdgcn_fence(__ATOMIC_ACQUIRE, "agent");
            asm volatile("s_waitcnt vmcnt(0)" ::: "memory");
        }
    }
    __syncthreads();
}

__device__ __forceinline__ int map_row(int mapid, int n) {
    if (mapid == 1) { const int seg = n >> 10, c = n & 1023;
        if (seg == 0) return c; if (seg == 1) return 1024 + (c >> 7) * 256 + (c & 127); if (seg == 2) return 1024 + (c >> 7) * 256 + 128 + (c & 127);
        return 3072 + (seg - 3) * 1024 + c; }
    if (mapid == 2) { if (n < DFF) return (n >> 7) * 256 + (n & 127); const int c = n - DFF; return (c >> 7) * 256 + 128 + (c & 127); }
    return n;
}
__device__ __forceinline__ void transpose_item(const float* W, int K, int N, bf16* WT, int mapid, LAS float* scr, int item, int lane) {
    const int nblk = N / 32, kb = item / nblk, nb = item % nblk, k0 = 64 * kb, n0 = 32 * nb;
#pragma unroll 8
    for (int i = 0; i < 32; ++i) { const int kk = 2 * i + (lane >> 5); scr[kk * 33 + (lane & 31)] = __builtin_nontemporal_load(W + (size_t)(k0 + kk) * N + n0 + (lane & 31)); }
    LDS_WAIT(); asm volatile("" ::: "memory");
    const int c = lane & 7; const int r0 = map_row(mapid, n0);
#pragma unroll
    for (int j = 0; j < 4; ++j) { const int n = (lane >> 3) + 8 * j; const LAS float* s = scr + (8 * c) * 33 + n;
        v4u o; o.x = cvt_pk_bf16(s[0 * 33], s[1 * 33]); o.y = cvt_pk_bf16(s[2 * 33], s[3 * 33]); o.z = cvt_pk_bf16(s[4 * 33], s[5 * 33]); o.w = cvt_pk_bf16(s[6 * 33], s[7 * 33]);
        *(v4u*)(WT + (size_t)(r0 + n) * K + k0 + 8 * c) = o; }
    LDS_WAIT(); asm volatile("" ::: "memory");
}
__device__ __forceinline__ void rms_row_to_bf16(const float* xrow, const float* g, bf16* orow, int lane) {
    const f32x4* xr = (const f32x4*)xrow + lane; const f32x4* gr = (const f32x4*)g + lane;
    f32x4 v[4]; float s = 0.f;
#pragma unroll
    for (int j = 0; j < 4; ++j) { v[j] = __builtin_nontemporal_load(xr + 64 * j); s += (v[j].x * v[j].x + v[j].y * v[j].y) + (v[j].z * v[j].z + v[j].w * v[j].w); }
    const float rs = 1.0f / sqrtf(wave_sum(s) * (1.f / DM) + EPS);
    v2u* o8 = (v2u*)orow + lane;
#pragma unroll
    for (int j = 0; j < 4; ++j) { const f32x4 gg = gr[64 * j]; v2u w; w.x = cvt_pk_bf16(v[j].x * rs * gg.x, v[j].y * rs * gg.y); w.y = cvt_pk_bf16(v[j].z * rs * gg.z, v[j].w * rs * gg.w); o8[64 * j] = w; }
}
template <bool XIN_BF, bool XOUT_BF> __device__ __forceinline__ void row_phase(const bf16* T, const void* xinA, const void* xinB, void* xout, const float* gpost, const float* gpre, bf16* XN, int gw_, int NGW_, int lane_) {
    asm volatile("" : "+v"(lane_));
    f32x4 gp[4], gn[4];
#pragma unroll
    for (int j = 0; j < 4; ++j) { gp[j] = ((const f32x4*)gpost)[lane_ + 64 * j]; gn[j] = gpre ? ((const f32x4*)gpre)[lane_ + 64 * j] : (f32x4){0.f, 0.f, 0.f, 0.f}; }
    for (int r = gw_; r < MT; r += NGW_) {
        const v2u* tr = (const v2u*)(T + (size_t)r * DM) + lane_;
        f32x4 t[4], x[4]; float s = 0.f;
#pragma unroll
        for (int j = 0; j < 4; ++j) { const v2u w = __builtin_nontemporal_load(tr + 64 * j); t[j] = (f32x4){bflo(w.x), bfhi(w.x), bflo(w.y), bfhi(w.y)}; s += (t[j].x * t[j].x + t[j].y * t[j].y) + (t[j].z * t[j].z + t[j].w * t[j].w); }
        if (XIN_BF) { const v2u* xr = (const v2u*)((const bf16*)xinA + (size_t)r * DM) + lane_;
#pragma unroll
            for (int j = 0; j < 4; ++j) { const v2u w = __builtin_nontemporal_load(xr + 64 * j); x[j] = (f32x4){bflo(w.x), bfhi(w.x), bflo(w.y), bfhi(w.y)}; } }
        else { const f32x4* xr = (const f32x4*)((r < MP) ? (const float*)xinA + (size_t)r * DM : (const float*)xinB + (size_t)(r - MP) * DM) + lane_;
#pragma unroll
            for (int j = 0; j < 4; ++j) x[j] = xr[64 * j]; }
        const float rs = 1.0f / sqrtf(wave_sum(s) * (1.f / DM) + EPS);
        float s2 = 0.f;
#pragma unroll
        for (int j = 0; j < 4; ++j) { x[j] = x[j] + t[j] * rs * gp[j]; s2 += (x[j].x * x[j].x + x[j].y * x[j].y) + (x[j].z * x[j].z + x[j].w * x[j].w); }
        if (XOUT_BF) { v2u* xo = (v2u*)((bf16*)xout + (size_t)r * DM) + lane_;
#pragma unroll
            for (int j = 0; j < 4; ++j) { v2u w; w.x = cvt_pk_bf16(x[j].x, x[j].y); w.y = cvt_pk_bf16(x[j].z, x[j].w); __builtin_nontemporal_store(w, xo + 64 * j); } }
        else { f32x4* xo = (f32x4*)((float*)xout + (size_t)r * DM) + lane_;
#pragma unroll
            for (int j = 0; j < 4; ++j) __builtin_nontemporal_store(x[j], xo + 64 * j); }
        if (XN) { const float rs2 = 1.0f / sqrtf(wave_sum(s2) * (1.f / DM) + EPS); v2u* o8 = (v2u*)(XN + (size_t)r * DM) + lane_;
#pragma unroll
            for (int j = 0; j < 4; ++j) { v2u w; w.x = cvt_pk_bf16(x[j].x * rs2 * gn[j].x, x[j].y * rs2 * gn[j].y); w.y = cvt_pk_bf16(x[j].z * rs2 * gn[j].z, x[j].w * rs2 * gn[j].w); o8[64 * j] = w; } }
    }
}

struct LayerIn { const float *sca, *scb, *sh, *caw, *cbw, *cbb, *wga, *bga, *wgx, *bgx, *lam; };
__device__ __forceinline__ float fsig(float x) { return __builtin_amdgcn_rcpf(1.0f + __expf(-x)); }
struct ConvA { const bf16* HB; const bf16* G; bf16* CA; float* pca; float* sa; };
__device__ __forceinline__ void bf8_to_f(const v4u w, float* g) { g[0] = bflo(w.x); g[1] = bfhi(w.x); g[2] = bflo(w.y); g[3] = bfhi(w.y); g[4] = bflo(w.z); g[5] = bfhi(w.z); g[6] = bflo(w.w); g[7] = bfhi(w.w); }
struct ConvAReg { v4u w0, wh, w1, w2; };
__device__ __forceinline__ void conva_load(const ConvA& C, int it, ConvAReg& R) {
        const int r = it >> 7, c = (it & 127) * 8;
        const int t = (r < MP) ? (r & (SEQ - 1)) : ((r - MP) & 7);
        R.w0 = *(const v4u*)(C.G + (size_t)r * DM + c); R.wh = __builtin_nontemporal_load((const v4u*)(C.HB + (size_t)r * DM + c));
        R.w1 = *(const v4u*)(C.G + (size_t)(r - (t >= 1 ? 1 : 0)) * DM + c); R.w2 = *(const v4u*)(C.G + (size_t)(r - (t >= 2 ? 2 : 0)) * DM + c);
}
__device__ __forceinline__ void conva_finish(const ConvA& C, const LayerIn& L, int it, const ConvAReg& R) {
        const int r = it >> 7, c = (it & 127) * 8;
        int t, b, TL; const bool smp = (r >= MP);
        if (!smp) { t = r & (SEQ - 1); b = r >> 11; TL = SEQ; } else { const int s = r - MP; t = s & 7; b = s >> 3; TL = DSEQ; }
        float g0[8], g1[8], g2[8], hb[8];
        bf8_to_f(R.w0, g0); bf8_to_f(R.wh, hb); bf8_to_f(R.w1, g1); bf8_to_f(R.w2, g2);
        if (t < 2) {
            if (smp) { const float* p2 = L.sca + ((size_t)b * 2 + t) * DM + c;
#pragma unroll
                for (int i = 0; i < 8; ++i) g2[i] = p2[i];
                if (t < 1) { const float* p1 = L.sca + ((size_t)b * 2 + 1) * DM + c;
#pragma unroll
                    for (int i = 0; i < 8; ++i) g1[i] = p1[i]; } }
            else {
#pragma unroll
                for (int i = 0; i < 8; ++i) { g2[i] = 0.f; if (t < 1) g1[i] = 0.f; } }
        }
        const f32x4 c0a = *(const f32x4*)(L.caw + c), c0b = *(const f32x4*)(L.caw + c + 4), c1a = *(const f32x4*)(L.caw + DM + c), c1b = *(const f32x4*)(L.caw + DM + c + 4), c2a = *(const f32x4*)(L.caw + 2 * DM + c), c2b = *(const f32x4*)(L.caw + 2 * DM + c + 4);
        float y[8];
#pragma unroll
        for (int i = 0; i < 8; ++i) { const float k0 = i < 4 ? c0a[i & 3] : c0b[i & 3], k1 = i < 4 ? c1a[i & 3] : c1b[i & 3], k2 = i < 4 ? c2a[i & 3] : c2b[i & 3]; y[i] = hb[i] * (k0 * g2[i] + k1 * g1[i] + k2 * g0[i]); }
        v4u o; o.x = cvt_pk_bf16(y[0], y[1]); o.y = cvt_pk_bf16(y[2], y[3]); o.z = cvt_pk_bf16(y[4], y[5]); o.w = cvt_pk_bf16(y[6], y[7]);
        *(v4u*)(C.CA + (size_t)r * DM + c) = o;
        if (t >= TL - 2) { float* dst = (smp ? C.sa : C.pca) + ((size_t)b * 2 + (t - (TL - 2))) * DM + c;
            *(f32x4*)dst = (f32x4){g0[0], g0[1], g0[2], g0[3]}; *(f32x4*)(dst + 4) = (f32x4){g0[4], g0[5], g0[6], g0[7]}; }
}
__device__ __forceinline__ void conva_item(const ConvA& C, const LayerIn& L, int it) { ConvAReg R; conva_load(C, it, R); conva_finish(C, L, it, R); }

constexpr int SC_UE = 0;
constexpr int SC_UCB = 45056;
constexpr int SC_UCF = 63488;
constexpr int SC_AA = 81920;
constexpr int SC_BB = 98304;
constexpr int SC_SEGA = 114688;
constexpr int SC_SEGB = 116736;
constexpr int SC_HIN = 118784;
constexpr int SC_HOUT = 120832;
constexpr int SC_WGT = 129024;
__device__ __forceinline__ void scan_unit(LAS unsigned char* lds, const bf16* U, bf16* HS, const LayerIn& L, float* pcb, float* ph, float* sb, float* sh, int kind, int sidx, int cgi, const ConvA& CV, int& cv_it, int cv_stride) {
    int tid_ = threadIdx.x; asm volatile("" : "+v"(tid_));
    const int tid = tid_, lane = tid & 63, w = tid >> 6, fr = lane & 15, fq = lane >> 4;
    const int nblk = cgi >> 1, cgh = cgi & 1, c0 = nblk * 64, cm0 = c0 + 32 * cgh;
    LAS float* UE = (LAS float*)(lds + SC_UE); LAS bf16* UCB = (LAS bf16*)(lds + SC_UCB); LAS float* UCF = (LAS float*)(lds + SC_UCF);
    LAS float* AA = (LAS float*)(lds + SC_AA); LAS float* BB = (LAS float*)(lds + SC_BB); LAS float* SEGA = (LAS float*)(lds + SC_SEGA);
    LAS float* SEGB = (LAS float*)(lds + SC_SEGB); LAS float* HIN = (LAS float*)(lds + SC_HIN); LAS bf16* HOUT = (LAS bf16*)(lds + SC_HOUT);
    LAS v4u* WGT = (LAS v4u*)(lds + SC_WGT);
#pragma unroll
    for (int nt = 0; nt < 2; ++nt)
#pragma unroll
        for (int ks = 0; ks < 2; ++ks) { const int j = 32 * cgh + 16 * nt + fr; const float* pa = L.wga + ((size_t)nblk * 64 + 32 * ks + 8 * fq) * 64 + j; const float* px = L.wgx + ((size_t)nblk * 64 + 32 * ks + 8 * fq) * 64 + j;
            unsigned a0 = cvt_pk_bf16(pa[0], pa[64]), a1 = cvt_pk_bf16(pa[128], pa[192]), a2 = cvt_pk_bf16(pa[256], pa[320]), a3 = cvt_pk_bf16(pa[384], pa[448]);
            unsigned x0 = cvt_pk_bf16(px[0], px[64]), x1 = cvt_pk_bf16(px[128], px[192]), x2 = cvt_pk_bf16(px[256], px[320]), x3 = cvt_pk_bf16(px[384], px[448]);
            v4u va = {a0, a1, a2, a3}, vx = {x0, x1, x2, x3};
            WGT[((nt * 2 + ks) * 2 + 0) * 64 + lane] = va; WGT[((nt * 2 + ks) * 2 + 1) * 64 + lane] = vx; }
    float ba[2], bx[2], sp8[2];
#pragma unroll
    for (int nt = 0; nt < 2; ++nt) { const int ch = cm0 + 16 * nt + fr; ba[nt] = L.bga[ch]; bx[nt] = L.bgx[ch]; sp8[nt] = 8.0f * log1pf(expf(-L.lam[ch])); }
    const int cgq = lane & 15;
    const f32x4 cw0 = *(const f32x4*)(L.cbw + c0 + 4 * cgq), cw1 = *(const f32x4*)(L.cbw + DM + c0 + 4 * cgq), cw2 = *(const f32x4*)(L.cbw + 2 * DM + c0 + 4 * cgq), cw3 = *(const f32x4*)(L.cbw + 3 * DM + c0 + 4 * cgq), cbias = *(const f32x4*)(L.cbb + c0 + 4 * cgq);
    float carry[2] = {0.f, 0.f};
    const int nch = (kind == 0) ? SEQ / 128 : 1;
    v4u pre0 = {0u, 0u, 0u, 0u}, pre1 = pre0, pre2 = pre0;
    int pt_[3], pc_[3], pl_[3];
#pragma unroll
    for (int i = 0; i < 3; ++i) { const int idx_ = tid + 512 * i, seg_ = idx_ / 88, rem_ = idx_ - seg_ * 88, j_ = rem_ >> 3, c8_ = rem_ & 7; pt_[i] = seg_ * 8 + j_ - 3; pc_[i] = c0 + 8 * c8_; pl_[i] = (seg_ * 11 + j_) * 64 + 8 * c8_; }
    const bool p2ok = tid < 1408 - 1024;
#define SC_PIECE(i, ckk, dstv) do { if ((i) < 2 || p2ok) { const int t_ = (ckk) * 128 + pt_[i]; \
        const v4u ld_ = *(const v4u*)(U + ((size_t)sidx * SEQ + (t_ < 0 ? 0 : t_)) * DM + pc_[i]); dstv = (t_ < 0) ? (v4u){0u, 0u, 0u, 0u} : ld_; } } while (0)
#define SC_PUT(i, srcv) do { if ((i) < 2 || p2ok) { LAS float* d_ = UE + pl_[i]; \
        *(LAS f32x4*)d_ = (f32x4){bflo(srcv.x), bfhi(srcv.x), bflo(srcv.y), bfhi(srcv.y)}; *(LAS f32x4*)(d_ + 4) = (f32x4){bflo(srcv.z), bfhi(srcv.z), bflo(srcv.w), bfhi(srcv.w)}; } } while (0)
    if (kind == 0) { SC_PIECE(0, 0, pre0); SC_PIECE(1, 0, pre1); SC_PIECE(2, 0, pre2); }
    for (int ck = 0; ck < nch; ++ck) {
        if (kind == 0) {
            SC_PUT(0, pre0); SC_PUT(1, pre1); SC_PUT(2, pre2);
            if (ck + 1 < nch) { SC_PIECE(0, ck + 1, pre0); SC_PIECE(1, ck + 1, pre1); SC_PIECE(2, ck + 1, pre2); }
        } else {
        for (int idx = tid; idx < 16 * 11 * 8; idx += 512) {
            const int seg = idx / 88, rem = idx - seg * 88, j = rem >> 3, c8 = rem & 7; float v[8];
            const int sq = sidx * 16 + seg;
            if (j < 3) { const float* p = L.scb + ((size_t)sq * 3 + j) * DM + c0 + 8 * c8; const f32x4 p0 = *(const f32x4*)p, p1 = *(const f32x4*)(p + 4);
                    v[0] = p0.x; v[1] = p0.y; v[2] = p0.z; v[3] = p0.w; v[4] = p1.x; v[5] = p1.y; v[6] = p1.z; v[7] = p1.w; }
            else { const v4u wv = *(const v4u*)(U + ((size_t)MP + sq * 8 + (j - 3)) * DM + c0 + 8 * c8); v[0] = bflo(wv.x); v[1] = bfhi(wv.x); v[2] = bflo(wv.y); v[3] = bfhi(wv.y); v[4] = bflo(wv.z); v[5] = bfhi(wv.z); v[6] = bflo(wv.w); v[7] = bfhi(wv.w); }
            LAS float* d = UE + (seg * 11 + j) * 64 + 8 * c8;
            *(LAS f32x4*)d = (f32x4){v[0], v[1], v[2], v[3]}; *(LAS f32x4*)(d + 4) = (f32x4){v[4], v[5], v[6], v[7]};
        }
        }
#if CONVA_INTERLEAVE
        ConvAReg cvr; const int cv_cur = cv_it; const bool cv_do = cv_cur < MT * 128;
        if (cv_do) { conva_load(CV, cv_cur, cvr); cv_it += cv_stride; }
#endif
        __syncthreads();
        for (int r1_ = 0; r1_ < REP_S1; ++r1_)
        { const int tk0 = 16 * w + 4 * fq, seg = tk0 >> 3, tt0 = tk0 & 7; const LAS float* p = UE + (seg * 11 + tt0) * 64 + 4 * cgq;
          f32x4 ur[7];
#pragma unroll
          for (int j = 0; j < 7; ++j) ur[j] = *(const LAS f32x4*)(p + 64 * j);
#pragma unroll
          for (int i = 0; i < 4; ++i) { const f32x4 uc = cbias + cw0 * ur[i] + cw1 * ur[i + 1] + cw2 * ur[i + 2] + cw3 * ur[i + 3];
              v2u pk; pk.x = cvt_pk_bf16(uc.x, uc.y); pk.y = cvt_pk_bf16(uc.z, uc.w); *(LAS v2u*)(UCB + (tk0 + i) * 72 + 4 * cgq) = pk;
              if ((cgq >> 3) == cgh) *(LAS f32x4*)(UCF + (tk0 + i) * 36 + 4 * (cgq & 7)) = uc; } }
        if (kind == 1 || ck == nch - 1)
        for (int idx = tid; idx < 16 * 3 * 32; idx += 512) { const int seg = idx / 96, jj = (idx >> 5) % 3, c = idx & 31; const float val = UE[(seg * 11 + 8 + jj) * 64 + 32 * cgh + c];
            if (kind == 1) sb[((size_t)(sidx * 16 + seg) * 3 + jj) * DM + cm0 + c] = val;
            else if (ck == nch - 1 && seg == 15) pcb[((size_t)sidx * 3 + jj) * DM + cm0 + c] = val; }
        LDS_WAIT(); asm volatile("" ::: "memory");
        f32x4 ra[2], rx[2];
        { bf16x8 af[2];
#pragma unroll
          for (int ks = 0; ks < 2; ++ks) af[ks] = *(const LAS bf16x8*)(UCB + (16 * w + fr) * 72 + 32 * ks + 8 * fq);
#pragma unroll
          for (int nt = 0; nt < 2; ++nt) { ra[nt] = (f32x4){0.f, 0.f, 0.f, 0.f}; rx[nt] = (f32x4){0.f, 0.f, 0.f, 0.f};
#pragma unroll
              for (int ks = 0; ks < 2; ++ks) { const bf16x8 wa_ = __builtin_bit_cast(bf16x8, WGT[((nt * 2 + ks) * 2 + 0) * 64 + lane]), wx_ = __builtin_bit_cast(bf16x8, WGT[((nt * 2 + ks) * 2 + 1) * 64 + lane]);
                  ra[nt] = __builtin_amdgcn_mfma_f32_16x16x32_bf16(af[ks], wa_, ra[nt], 0, 0, 0); rx[nt] = __builtin_amdgcn_mfma_f32_16x16x32_bf16(af[ks], wx_, rx[nt], 0, 0, 0); } } }
        float Ap[2][4], Bp[2][4], eA[2], eB[2], At[2], Bt[2];
#pragma unroll
        for (int nt = 0; nt < 2; ++nt) {
#pragma unroll
            for (int rg = 0; rg < 4; ++rg) { const int tk = 16 * w + 4 * fq + rg, c = 16 * nt + fr; const float uc = UCF[tk * 36 + c];
                const float r = fsig(ra[nt][rg] + ba[nt]), ii = fsig(rx[nt][rg] + bx[nt]); const float la = -sp8[nt] * r;
                const float av = __expf(la), bv = __builtin_amdgcn_sqrtf(fmaxf(1.0f - av * av, 0.f)) * ii * uc;
                if (rg == 0) { Ap[nt][0] = av; Bp[nt][0] = bv; } else { Ap[nt][rg] = av * Ap[nt][rg - 1]; Bp[nt][rg] = av * Bp[nt][rg - 1] + bv; } }
            float A_ = Ap[nt][3], B_ = Bp[nt][3];
            { const float pA = __shfl_up(A_, 16), pB = __shfl_up(B_, 16); const bool c1 = (kind == 0) ? (fq >= 1) : ((fq & 1) != 0); if (c1) { B_ = A_ * pB + B_; A_ = pA * A_; } }
            if (kind == 0) { const float pA = __shfl_up(A_, 32), pB = __shfl_up(B_, 32); if (fq >= 2) { B_ = A_ * pB + B_; A_ = pA * A_; } }
            { float xA = __shfl_up(A_, 16), xB = __shfl_up(B_, 16); const bool first = (kind == 0) ? (fq == 0) : ((fq & 1) == 0); if (first) { xA = 1.f; xB = 0.f; } eA[nt] = xA; eB[nt] = xB; }
            At[nt] = A_; Bt[nt] = B_;
        }
        float hst[2];
        if (kind == 0) {
            typedef float f32x2s __attribute__((ext_vector_type(2)));
            LAS f32x2s* SW = (LAS f32x2s*)(lds + SC_SEGA) + (ck & 1) * 256;
            if (fq == 3) { SW[w * 32 + fr] = (f32x2s){At[0], Bt[0]}; SW[w * 32 + 16 + fr] = (f32x2s){At[1], Bt[1]}; }
            __syncthreads();
#pragma unroll
            for (int nt = 0; nt < 2; ++nt) { float h = carry[nt], hin = 0.f;
#pragma unroll
                for (int ww = 0; ww < 8; ++ww) { const f32x2s ab = SW[ww * 32 + 16 * nt + fr]; if (ww == w) hin = h; h = ab.x * h + ab.y; }
                carry[nt] = h; hst[nt] = eA[nt] * hin + eB[nt]; }
        } else {
#pragma unroll
            for (int nt = 0; nt < 2; ++nt) { const float hin = L.sh[(size_t)(sidx * 16 + 2 * w + (fq >> 1)) * DM + cm0 + 16 * nt + fr]; hst[nt] = eA[nt] * hin + eB[nt]; }
        }
#pragma unroll
        for (int nt = 0; nt < 2; ++nt) {
#pragma unroll
            for (int rg = 0; rg < 4; ++rg) { const float h = Ap[nt][rg] * hst[nt] + Bp[nt][rg]; HOUT[(16 * w + 4 * fq + rg) * 32 + 16 * nt + fr] = (bf16)(cvt_pk_bf16(h, 0.f) & 0xffffu);
                if (rg == 3 && kind == 1 && (fq & 1)) sh[(size_t)(sidx * 16 + 2 * w + (fq >> 1)) * DM + cm0 + 16 * nt + fr] = h; }
            if (kind == 0 && ck == nch - 1 && w == 0 && fq == 0) ph[(size_t)sidx * DM + cm0 + 16 * nt + fr] = carry[nt];
        }
        LDS_WAIT(); asm volatile("" ::: "memory");
        for (int r3_ = 0; r3_ < REP_S3; ++r3_)
        { const int row = tid >> 2, part = tid & 3; const v4u v = *(const LAS v4u*)(HOUT + row * 32 + part * 8);
          const size_t grow = (kind == 0) ? (size_t)sidx * SEQ + ck * 128 + row : (size_t)MP + (size_t)sidx * 128 + row;
          *(v4u*)(HS + grow * DM + cm0 + part * 8) = v; }
#if CONVA_INTERLEAVE
        if (cv_do) conva_finish(CV, L, cv_cur, cvr);
#endif
    }
    __syncthreads();
#undef SC_PIECE
#undef SC_PUT
}

constexpr int KSTP = 272;
constexpr int KSTR = 264;
constexpr float SM_C = 0.0625f * 1.4426950408889634f;
__device__ __forceinline__ void attn_prompt_unit(LAS unsigned char* lds, const bf16* Q, const bf16* KB, const bf16* VT, bf16* O, int b, int h, int qt) {
    int tid_ = threadIdx.x; asm volatile("" : "+v"(tid_));
    const int tid = tid_, lane = tid & 63, w = tid >> 6, fr = lane & 15, fq = lane >> 4;
    LAS bf16* TL = (LAS bf16*)lds; LAS bf16* PW = (LAS bf16*)(lds + 64 * KSTP * 2 + w * (16 * KSTP * 2));
    const size_t qrow0 = (size_t)b * SEQ + qt * 128 + 16 * w;
    const int pm_ = tid >> 5, pc_ = (tid & 31) * 8;
    const bf16* ksrc = KB + ((size_t)b * NMEM + pm_) * DM + h * HD + pc_;
    const bf16* vsrc = VT + ((size_t)(b * NH + h) * HD + pm_) * NMEM + pc_;
    v4u nx0, nx1, nx2, nx3;
#define AT_LOADK(jt) do { const bf16* p_ = ksrc + (size_t)(64 * (jt)) * DM; nx0 = *(const v4u*)p_; nx1 = *(const v4u*)(p_ + 16 * DM); nx2 = *(const v4u*)(p_ + 32 * DM); nx3 = *(const v4u*)(p_ + 48 * DM); } while (0)
#define AT_LOADV(jt) do { const bf16* p_ = vsrc + (size_t)(64 * (jt)) * NMEM; nx0 = *(const v4u*)p_; nx1 = *(const v4u*)(p_ + 16 * NMEM); nx2 = *(const v4u*)(p_ + 32 * NMEM); nx3 = *(const v4u*)(p_ + 48 * NMEM); } while (0)
#define AT_PUT() do { LAS bf16* d_ = TL + pm_ * KSTP + pc_; *(LAS v4u*)d_ = nx0; *(LAS v4u*)(d_ + 16 * KSTP) = nx1; *(LAS v4u*)(d_ + 32 * KSTP) = nx2; *(LAS v4u*)(d_ + 48 * KSTP) = nx3; } while (0)
    AT_LOADK(0);
    bf16x8 qf[8];
#pragma unroll
    for (int ks = 0; ks < 8; ++ks) qf[ks] = *(const bf16x8*)(Q + (qrow0 + fr) * DM + h * HD + 32 * ks + 8 * fq);
    f32x4 s[16];
#pragma unroll
    for (int i = 0; i < 16; ++i) s[i] = (f32x4){0.f, 0.f, 0.f, 0.f};
#pragma unroll
    for (int jt = 0; jt < 4; ++jt) {
        AT_PUT();
        __syncthreads();
        if (jt < 3) AT_LOADK(jt + 1); else AT_LOADV(0);
        { bf16x8 fb[2][8];
#pragma unroll
          for (int ks = 0; ks < 8; ++ks) fb[0][ks] = *(const LAS bf16x8*)(TL + fr * KSTP + 32 * ks + 8 * fq);
#pragma unroll
          for (int nt = 0; nt < 4; ++nt) {
              if (nt < 3) {
#pragma unroll
                  for (int ks = 0; ks < 8; ++ks) fb[(nt + 1) & 1][ks] = *(const LAS bf16x8*)(TL + (16 * (nt + 1) + fr) * KSTP + 32 * ks + 8 * fq); }
              __builtin_amdgcn_sched_barrier(0); __builtin_amdgcn_s_setprio(1);
#pragma unroll
              for (int ks = 0; ks < 8; ++ks) s[4 * jt + nt] = __builtin_amdgcn_mfma_f32_16x16x32_bf16(fb[nt & 1][ks], qf[ks], s[4 * jt + nt], 0, 0, 0);
              __builtin_amdgcn_s_setprio(0); __builtin_amdgcn_sched_barrier(0);
          } }
        __syncthreads();
    }
    { float mx = s[0][0];
#pragma unroll
      for (int nt = 0; nt < 16; ++nt) mx = fmaxf(fmaxf(mx, fmaxf(s[nt][0], s[nt][1])), fmaxf(s[nt][2], s[nt][3]));
      mx = fmaxf(mx, __shfl_xor(mx, 16)); mx = fmaxf(mx, __shfl_xor(mx, 32));
      float sum = 0.f;
#pragma unroll
      for (int nt = 0; nt < 16; ++nt)
#pragma unroll
          for (int rg = 0; rg < 4; ++rg) { const float p = exp2f((s[nt][rg] - mx) * SM_C); s[nt][rg] = p; sum += p; }
      sum += __shfl_xor(sum, 16); sum += __shfl_xor(sum, 32);
      const float inv = 1.0f / sum;
#pragma unroll
      for (int nt = 0; nt < 16; ++nt) { v2u pk; pk.x = cvt_pk_bf16(s[nt][0] * inv, s[nt][1] * inv); pk.y = cvt_pk_bf16(s[nt][2] * inv, s[nt][3] * inv); *(LAS v2u*)(PW + fr * KSTP + 16 * nt + 4 * fq) = pk; } }
    LDS_WAIT(); asm volatile("" ::: "memory");
    bf16x8 pf[8];
#pragma unroll
    for (int ks = 0; ks < 8; ++ks) pf[ks] = *(const LAS bf16x8*)(PW + fr * KSTP + 32 * ks + 8 * fq);
#pragma unroll
    for (int jt = 0; jt < 4; ++jt) {
        AT_PUT();
        __syncthreads();
        if (jt < 3) AT_LOADV(jt + 1);
        { bf16x8 fb[2][8];
#pragma unroll
          for (int ks = 0; ks < 8; ++ks) fb[0][ks] = *(const LAS bf16x8*)(TL + fr * KSTP + 32 * ks + 8 * fq);
#pragma unroll
          for (int nt = 0; nt < 4; ++nt) { f32x4 o = (f32x4){0.f, 0.f, 0.f, 0.f};
              if (nt < 3) {
#pragma unroll
                  for (int ks = 0; ks < 8; ++ks) fb[(nt + 1) & 1][ks] = *(const LAS bf16x8*)(TL + (16 * (nt + 1) + fr) * KSTP + 32 * ks + 8 * fq); }
              __builtin_amdgcn_sched_barrier(0); __builtin_amdgcn_s_setprio(1);
#pragma unroll
              for (int ks = 0; ks < 8; ++ks) o = __builtin_amdgcn_mfma_f32_16x16x32_bf16(fb[nt & 1][ks], pf[ks], o, 0, 0, 0);
              __builtin_amdgcn_s_setprio(0); __builtin_amdgcn_sched_barrier(0);
              v2u pk; pk.x = cvt_pk_bf16(o[0], o[1]); pk.y = cvt_pk_bf16(o[2], o[3]);
              *(v2u*)(O + (qrow0 + fr) * DM + h * HD + 64 * jt + 16 * nt + 4 * fq) = pk; } }
        __syncthreads();
    }
#undef AT_LOADK
#undef AT_LOADV
#undef AT_PUT
}
__device__ __forceinline__ void attn_sample_units(LAS unsigned char* lds, const bf16* Q, const float* CK, const float* CV, bf16* O, int first, int stride) {
    int tid_ = threadIdx.x; asm volatile("" : "+v"(tid_));
    const int tid = tid_, lane = tid & 63, w = tid >> 6, fr = lane & 15, fq = lane >> 4;
    LAS bf16* KS = (LAS bf16*)lds; LAS bf16* PS = (LAS bf16*)(lds + 135168); LAS float* RED = (LAS float*)(lds + 143616);
    constexpr int KPF = 8;
    f32x4 kp[KPF];
#define AS_KBASE(u_) (CK + ((size_t)((u_) >> 2) * NMEM * NH + ((u_) & 3)) * HD)
#define AS_KLOAD(u_) do { const float* kb_ = AS_KBASE(u_); _Pragma("unroll") for (int i = 0; i < KPF; ++i) { const int idx = i * 512 + tid, m = idx >> 6, d4 = idx & 63; kp[i] = __builtin_nontemporal_load((const f32x4*)(kb_ + (size_t)m * DM + 4 * d4)); } } while (0)
    int u = first;
    if (u < 512) AS_KLOAD(u);
    for (; u < 512; u += stride) {
        const int b = u >> 2, h = u & 3;
        const float* kbase = AS_KBASE(u);
        const float* vbase = CV + ((size_t)b * NMEM * NH + h) * HD;
#pragma unroll
        for (int i = 0; i < KPF; ++i) { const int idx = i * 512 + tid, m = idx >> 6, d4 = idx & 63; v2u o; o.x = cvt_pk_bf16(kp[i].x, kp[i].y); o.y = cvt_pk_bf16(kp[i].z, kp[i].w); *(LAS v2u*)(KS + m * KSTR + 4 * d4) = o; }
#pragma unroll 8
        for (int i = KPF; i < 32; ++i) { const int idx = i * 512 + tid, m = idx >> 6, d4 = idx & 63; const f32x4 v = __builtin_nontemporal_load((const f32x4*)(kbase + (size_t)m * DM + 4 * d4));
            v2u o; o.x = cvt_pk_bf16(v.x, v.y); o.y = cvt_pk_bf16(v.z, v.w); *(LAS v2u*)(KS + m * KSTR + 4 * d4) = o; }
        bf16x8 qf[8];
#pragma unroll
        for (int ks = 0; ks < 8; ++ks) { if (fr < 8) qf[ks] = *(const bf16x8*)(Q + ((size_t)MP + b * DSEQ + fr) * DM + h * HD + 32 * ks + 8 * fq); else qf[ks] = (bf16x8){0, 0, 0, 0, 0, 0, 0, 0}; }
        __syncthreads();
        f32x4 vp[16];
#pragma unroll
        for (int i = 0; i < 8; ++i) { const int mp = i * 8 + (lane & 7), d4 = w * 8 + (lane >> 3);
            vp[2 * i] = __builtin_nontemporal_load((const f32x4*)(vbase + (size_t)(2 * mp) * DM + 4 * d4)); vp[2 * i + 1] = __builtin_nontemporal_load((const f32x4*)(vbase + (size_t)(2 * mp + 1) * DM + 4 * d4)); }
        f32x4 s[2];
#pragma unroll
        for (int nt = 0; nt < 2; ++nt) { s[nt] = (f32x4){0.f, 0.f, 0.f, 0.f};
#pragma unroll
            for (int ks = 0; ks < 8; ++ks) { const bf16x8 bfr = *(const LAS bf16x8*)(KS + (32 * w + 16 * nt + fr) * KSTR + 32 * ks + 8 * fq); s[nt] = __builtin_amdgcn_mfma_f32_16x16x32_bf16(bfr, qf[ks], s[nt], 0, 0, 0); } }
        { float m_ = fmaxf(fmaxf(fmaxf(s[0][0], s[0][1]), fmaxf(s[0][2], s[0][3])), fmaxf(fmaxf(s[1][0], s[1][1]), fmaxf(s[1][2], s[1][3])));
          m_ = fmaxf(m_, __shfl_xor(m_, 16)); m_ = fmaxf(m_, __shfl_xor(m_, 32));
          if (fq == 0) RED[w * 16 + fr] = m_; }
        __syncthreads();
        { float m_ = RED[fr];
#pragma unroll
          for (int ww = 1; ww < 8; ++ww) m_ = fmaxf(m_, RED[ww * 16 + fr]);
          float sum = 0.f;
#pragma unroll
          for (int nt = 0; nt < 2; ++nt)
#pragma unroll
              for (int rg = 0; rg < 4; ++rg) { const float p = exp2f((s[nt][rg] - m_) * SM_C); s[nt][rg] = p; sum += p; }
          sum += __shfl_xor(sum, 16); sum += __shfl_xor(sum, 32);
          if (fq == 0) RED[128 + w * 16 + fr] = sum; }
#pragma unroll
        for (int i = 0; i < 8; ++i) { const int mp = i * 8 + (lane & 7), d4 = w * 8 + (lane >> 3); const f32x4 v0 = vp[2 * i], v1 = vp[2 * i + 1];
            LAS unsigned* dst = (LAS unsigned*)(KS + (4 * d4) * KSTR + 2 * mp);
            dst[0] = cvt_pk_bf16(v0.x, v1.x); dst[KSTR / 2] = cvt_pk_bf16(v0.y, v1.y); dst[KSTR] = cvt_pk_bf16(v0.z, v1.z); dst[3 * KSTR / 2] = cvt_pk_bf16(v0.w, v1.w); }
#pragma unroll 4
        for (int i = 8; i < 16; ++i) { const int mp = i * 8 + (lane & 7), d4 = w * 8 + (lane >> 3);
            const f32x4 v0 = __builtin_nontemporal_load((const f32x4*)(vbase + (size_t)(2 * mp) * DM + 4 * d4)), v1 = __builtin_nontemporal_load((const f32x4*)(vbase + (size_t)(2 * mp + 1) * DM + 4 * d4));
            LAS unsigned* dst = (LAS unsigned*)(KS + (4 * d4) * KSTR + 2 * mp);
            dst[0] = cvt_pk_bf16(v0.x, v1.x); dst[KSTR / 2] = cvt_pk_bf16(v0.y, v1.y); dst[KSTR] = cvt_pk_bf16(v0.z, v1.z); dst[3 * KSTR / 2] = cvt_pk_bf16(v0.w, v1.w); }
        __syncthreads();
        { float tot = RED[128 + fr];
#pragma unroll
          for (int ww = 1; ww < 8; ++ww) tot += RED[128 + ww * 16 + fr];
          const float inv = 1.0f / tot;
#pragma unroll
          for (int nt = 0; nt < 2; ++nt) { v2u pk; pk.x = cvt_pk_bf16(s[nt][0] * inv, s[nt][1] * inv); pk.y = cvt_pk_bf16(s[nt][2] * inv, s[nt][3] * inv); *(LAS v2u*)(PS + fr * KSTR + 32 * w + 16 * nt + 4 * fq) = pk; } }
        __syncthreads();
        if (u + stride < 512) AS_KLOAD(u + stride);
#pragma unroll
        for (int nt = 0; nt < 2; ++nt) { f32x4 o = (f32x4){0.f, 0.f, 0.f, 0.f};
#pragma unroll
            for (int ks = 0; ks < 8; ++ks) { const bf16x8 pfr = *(const LAS bf16x8*)(PS + fr * KSTR + 32 * ks + 8 * fq); const bf16x8 bfr = *(const LAS bf16x8*)(KS + (32 * w + 16 * nt + fr) * KSTR + 32 * ks + 8 * fq);
                o = __builtin_amdgcn_mfma_f32_16x16x32_bf16(bfr, pfr, o, 0, 0, 0); }
            if (fr < 8) { v2u pk; pk.x = cvt_pk_bf16(o[0], o[1]); pk.y = cvt_pk_bf16(o[2], o[3]); *(v2u*)(O + ((size_t)MP + b * DSEQ + fr) * DM + h * HD + 32 * w + 16 * nt + 4 * fq) = pk; } }
        __syncthreads();
    }
#undef AS_KBASE
#undef AS_KLOAD
}
template <int KS, class Epi> __device__ __forceinline__ void mini_gemm(LAS unsigned char* lds, const bf16* A, const bf16* Bt, int K, int N, int row_base, int nrows, const Epi& E, int first, int stride) {
    int tid_ = threadIdx.x; asm volatile("" : "+v"(tid_));
    const int lane = tid_ & 63, w = tid_ >> 6, fr = lane & 15, fq = lane >> 4;
    const int ntn = N / 64, ntiles = (nrows / 64) * ntn;
    LAS f32x4* RED = (LAS f32x4*)lds;
    for (int t = first; t < ntiles; t += stride) {
        const int tm = t / ntn, tn = t - tm * ntn;
        const int r0 = row_base + tm * 64, c0 = tn * 64;
        const bf16* ap = A + (size_t)(r0 + fr) * K + 8 * fq + 32 * w * KS;
        const bf16* bp = Bt + (size_t)(c0 + fr) * K + 8 * fq + 32 * w * KS;
        f32x4 acc[4][4];
#pragma unroll
        for (int i = 0; i < 4; ++i)
#pragma unroll
            for (int j = 0; j < 4; ++j) acc[i][j] = (f32x4){0.f, 0.f, 0.f, 0.f};
#pragma unroll
        for (int k0 = 0; k0 < KS; k0 += 4) { bf16x8 a[4][4], b[4][4];
#pragma unroll
            for (int kk = 0; kk < 4; ++kk) if (k0 + kk < KS) {
#pragma unroll
                for (int i = 0; i < 4; ++i) { a[kk][i] = *(const bf16x8*)(ap + (size_t)(16 * i) * K + 32 * (k0 + kk)); b[kk][i] = *(const bf16x8*)(bp + (size_t)(16 * i) * K + 32 * (k0 + kk)); } }
            __builtin_amdgcn_sched_barrier(0);
#pragma unroll
            for (int kk = 0; kk < 4; ++kk) if (k0 + kk < KS) {
#pragma unroll
                for (int i = 0; i < 4; ++i)
#pragma unroll
                    for (int j = 0; j < 4; ++j) acc[i][j] = __builtin_amdgcn_mfma_f32_16x16x32_bf16(b[kk][j], a[kk][i], acc[i][j], 0, 0, 0); }
            __builtin_amdgcn_sched_barrier(0);
        }
#pragma unroll
        for (int i = 0; i < 4; ++i)
#pragma unroll
            for (int j = 0; j < 4; ++j) RED[(w * 16 + i * 4 + j) * 64 + lane] = acc[i][j];
        __syncthreads();
#pragma unroll
        for (int q = 0; q < 2; ++q) { const int st = 2 * w + q, mt = st >> 2, nt = st & 3; f32x4 v = RED[st * 64 + lane];
#pragma unroll
            for (int ww = 1; ww < 8; ++ww) v = v + RED[(ww * 16 + st) * 64 + lane];
            E.apply(r0 + 16 * mt + fr, c0 + 16 * nt + 4 * fq, v); }
        __syncthreads();
    }
}

__device__ __forceinline__ void mini_gemm_dual(LAS unsigned char* lds, const bf16* A1, const bf16* B1, const bf16* A2, const bf16* B2, const bf16* m1, const bf16* m2, bf16* Zo, int row_base, int nrows, int first, int stride) {
    int tid_ = threadIdx.x; asm volatile("" : "+v"(tid_));
    const int lane = tid_ & 63, w = tid_ >> 6, fr = lane & 15, fq = lane >> 4;
    constexpr int K = DM, KS = 4; const int ntn = DM / 64, ntiles = (nrows / 64) * ntn;
    LAS f32x4* RED = (LAS f32x4*)lds;
    for (int t = first; t < ntiles; t += stride) {
        const int tm = t / ntn, tn = t - tm * ntn;
        const int r0 = row_base + tm * 64, c0 = tn * 64;
        f32x4 zkeep[2];
#pragma unroll
        for (int pass = 0; pass < 2; ++pass) {
            const bf16* ap = (pass ? A2 : A1) + (size_t)(r0 + fr) * K + 8 * fq + 32 * w * KS;
            const bf16* bp = (pass ? B2 : B1) + (size_t)(c0 + fr) * K + 8 * fq + 32 * w * KS;
            f32x4 acc[4][4];
#pragma unroll
            for (int i = 0; i < 4; ++i)
#pragma unroll
                for (int j = 0; j < 4; ++j) acc[i][j] = (f32x4){0.f, 0.f, 0.f, 0.f};
            bf16x8 a[4][4], b[4][4];
#pragma unroll
            for (int kk = 0; kk < 4; ++kk)
#pragma unroll
                for (int i = 0; i < 4; ++i) { a[kk][i] = *(const bf16x8*)(ap + (size_t)(16 * i) * K + 32 * kk); b[kk][i] = *(const bf16x8*)(bp + (size_t)(16 * i) * K + 32 * kk); }
            __builtin_amdgcn_sched_barrier(0);
#pragma unroll
            for (int kk = 0; kk < 4; ++kk)
#pragma unroll
                for (int i = 0; i < 4; ++i)
#pragma unroll
                    for (int j = 0; j < 4; ++j) acc[i][j] = __builtin_amdgcn_mfma_f32_16x16x32_bf16(b[kk][j], a[kk][i], acc[i][j], 0, 0, 0);
            __builtin_amdgcn_sched_barrier(0);
#pragma unroll
            for (int i = 0; i < 4; ++i)
#pragma unroll
                for (int j = 0; j < 4; ++j) RED[(w * 16 + i * 4 + j) * 64 + lane] = acc[i][j];
            __syncthreads();
#pragma unroll
            for (int q = 0; q < 2; ++q) { const int st = 2 * w + q, mt = st >> 2, nt = st & 3; f32x4 v = RED[st * 64 + lane];
#pragma unroll
                for (int ww = 1; ww < 8; ++ww) v = v + RED[(ww * 16 + st) * 64 + lane];
                const size_t o = (size_t)(r0 + 16 * mt + fr) * DM + c0 + 16 * nt + 4 * fq;
                if (pass == 0) { zkeep[q] = v * pg8::ld_bf16x4(m1 + o); }
                else { pg8::st_bf16x4(Zo + o, zkeep[q] + v * pg8::ld_bf16x4(m2 + o)); } }
            __syncthreads();
        }
    }
}

struct Args { const float* in[26]; float* out; unsigned char* ws; };
typedef __attribute__((address_space(4))) const unsigned char* karg_t;
__device__ __forceinline__ const float* karg_in(int i) { karg_t p = (karg_t)__builtin_amdgcn_kernarg_segment_ptr(); asm volatile("" : "+s"(p)); return *(const float* __attribute__((address_space(4))) const*)(p + 8 * i); }
__device__ __forceinline__ float* karg_out() { karg_t p = (karg_t)__builtin_amdgcn_kernarg_segment_ptr(); asm volatile("" : "+s"(p)); return *(float* __attribute__((address_space(4))) const*)(p + 8 * 26); }
__device__ __forceinline__ unsigned char* karg_ws() { karg_t p = (karg_t)__builtin_amdgcn_kernarg_segment_ptr(); asm volatile("" : "+s"(p)); return *(unsigned char* __attribute__((address_space(4))) const*)(p + 8 * 27); }
#define ARGIN(i) karg_in(i)
__device__ __forceinline__ int opaque_i(int v) { asm volatile("" : "+s"(v)); return v; }
__device__ __forceinline__ int vcu_of(int g, int b) { return (g % 8 == 0) ? (b % 8) * (g / 8) + b / 8 : b; }
__global__ void __launch_bounds__(NWAVES * 64, 2) fwd_megakernel(Args args_unused) {
    extern __shared__ __attribute__((aligned(16))) unsigned char lds_raw[];
    LAS unsigned char* lds = (LAS unsigned char*)lds_raw;
#define tid ((int)threadIdx.x)
#define lane (tid & 63)
#define wave (__builtin_amdgcn_readfirstlane(tid >> 6))
#define G (opaque_i((int)gridDim.x))
#define bx ((int)blockIdx.x)
#define vcu (vcu_of(G, bx))
    for (int u = tid; u < 256; u += NWAVES * 64) ((LAS unsigned*)(lds + MISC_OFF))[u] = 0u;
    __syncthreads();
    XcdBarrier bar = xcd_barrier_post((unsigned*)(karg_ws() + WS_CTL) + CW_BAR, (volatile LAS unsigned*)(lds + MISC_OFF) + 8);
#define GRID_BAR() do { for (int rb_ = 0; rb_ < REP_BAR; ++rb_) xcd_barrier(bar); } while (0)
#define gw (vcu * NWAVES + wave)
#define NGW (G * NWAVES)
#define ws (karg_ws())
#define out (karg_out())
#define XN ((bf16*)(ws + WS_XN))
#define MN ((bf16*)(ws + WS_MN))
#define PROJ ((bf16*)(ws + WS_PROJ))
#define CA ((bf16*)(ws + WS_CA))
#define HS ((bf16*)(ws + WS_HS))
#define YC ((bf16*)(ws + WS_YC))
#define Z ((bf16*)(ws + WS_Z))
#define T ((bf16*)(ws + WS_T))
#define X ((bf16*)(ws + WS_X))
#define Qb ((bf16*)(ws + WS_Q))
#define Ob ((bf16*)(ws + WS_O))
#define ACT ((bf16*)(ws + WS_ACT))
#define MKB ((bf16*)(ws + WS_MKB))
#define MVT ((bf16*)(ws + WS_MVT))
#define gains (ARGIN(8))
#if (PHM >> 0) & 1
    for (int rp_ = 0; rp_ < REP_PRO; ++rp_) {
        LAS float* scr = (LAS float*)(lds + wave * 16384);
        constexpr int NIT = 10880;
        for (int it = gw; it < 2 * NIT; it += NGW) {
            const int l = it / NIT; int r = it - l * NIT; bf16* wb = (bf16*)(ws + WS_W + (size_t)l * W_LAYER);
            if (r < 3072) { transpose_item(ARGIN(9) + (size_t)l * DM * DIN, DM, DIN, (bf16*)((unsigned char*)wb + WO_IN), 1, scr, r, lane); continue; } r -= 3072;
            if (r < 512) { transpose_item(ARGIN(11) + (size_t)l * DM * DM, DM, DM, (bf16*)((unsigned char*)wb + WO_CO), 0, scr, r, lane); continue; } r -= 512;
            if (r < 512) { transpose_item(ARGIN(19) + (size_t)l * DM * DM, DM, DM, (bf16*)((unsigned char*)wb + WO_RO), 0, scr, r, lane); continue; } r -= 512;
            if (r < 512) { transpose_item(ARGIN(20) + (size_t)l * DM * DM, DM, DM, (bf16*)((unsigned char*)wb + WO_MIX), 0, scr, r, lane); continue; } r -= 512;
            if (r < 1024) { transpose_item(ARGIN(21) + (size_t)l * DM * 2 * DM, DM, 2 * DM, (bf16*)((unsigned char*)wb + WO_KV), 0, scr, r, lane); continue; } r -= 1024;
            if (r < 512) { transpose_item(ARGIN(22) + (size_t)l * DM * DM, DM, DM, (bf16*)((unsigned char*)wb + WO_Q), 0, scr, r, lane); continue; } r -= 512;
            if (r < 512) { transpose_item(ARGIN(23) + (size_t)l * DM * DM, DM, DM, (bf16*)((unsigned char*)wb + WO_O), 0, scr, r, lane); continue; } r -= 512;
            if (r < 2816) { transpose_item(ARGIN(24) + (size_t)l * DM * 2 * DFF, DM, 2 * DFF, (bf16*)((unsigned char*)wb + WO_FI), 2, scr, r, lane); continue; } r -= 2816;
            transpose_item(ARGIN(25) + (size_t)l * DFF * DM, DFF, DM, (bf16*)((unsigned char*)wb + WO_FO), 0, scr, r, lane);
        }
        for (int m = gw; m < MT; m += NGW) rms_row_to_bf16((m < MP) ? ARGIN(0) + (size_t)m * DM : ARGIN(1) + (size_t)(m - MP) * DM, gains, XN + (size_t)m * DM, lane);
        for (int m = gw; m < 2 * MROWS; m += NGW) { const int l = m / MROWS, rr = m - l * MROWS; rms_row_to_bf16(ARGIN(7) + (size_t)rr * DM, gains + ((size_t)l * 7 + 6) * DM, MN + (size_t)m * DM, lane); }
    }
    GRID_BAR();

#endif
#if (PHM >> 1) & 1
    for (int l = 0; l < DEPTH; ++l) {
        const bf16* wkv = (const bf16*)(ws + WS_W + (size_t)l * W_LAYER + WO_KV);
        pg8::Gemm g{MN + (size_t)l * MROWS * DM, wkv, MROWS, 2 * DM, DM}; pg8::StaticOrder S; const int cmk = bx - 96 - 64 * l;
        S.init(MROWS, 2 * DM, G, (G == 256) ? ((cmk >= 0 && cmk < 64) ? cmk : (1 << 20)) : bx);
        pg8::EpiMemKV E{out + OFF_PK + (size_t)l * MROWS * DM, out + OFF_PV + (size_t)l * MROWS * DM, MKB + (size_t)l * MROWS * DM, MVT + (size_t)l * MROWS * DM};
        pg8::gemm_phase<pg8::EpiMemKV, pg8::StaticOrder, true, true>(lds, g, S, E);
    }
#endif

    for (int l = 0; l < DEPTH; ++l) {
#define wl ((const unsigned char*)(ws + WS_W + (size_t)l * W_LAYER))
#define gl (gains + (size_t)l * 7 * DM)
#define MAKE_L() LayerIn L; L.sca = ARGIN(2) + (size_t)l * DB * 2 * DM; L.scb = ARGIN(3) + (size_t)l * DB * 3 * DM; L.sh = ARGIN(4) + (size_t)l * DB * DM; \
        L.caw = ARGIN(10) + (size_t)l * 3 * DM; L.cbw = ARGIN(12) + (size_t)l * 4 * DM; L.cbb = ARGIN(13) + (size_t)l * DM; \
        L.wga = ARGIN(14) + (size_t)l * 16 * 64 * 64; L.bga = ARGIN(15) + (size_t)l * DM; L.wgx = ARGIN(16) + (size_t)l * 16 * 64 * 64; L.bgx = ARGIN(17) + (size_t)l * DM; L.lam = ARGIN(18) + (size_t)l * DM
#if (PHM >> 2) & 1
        { pg8::Gemm g{XN, (const bf16*)(wl + WO_IN), MT, DIN, DM}; pg8::StaticOrder S; S.init(MT, DIN, G, bx); pg8::EpiInProj E{PROJ, SLOT};
          pg8::gemm_phase<pg8::EpiInProj, pg8::StaticOrder, true, true>(lds, g, S, E); }
        GRID_BAR();
#endif
#if (PHM >> 3) & 1
        for (int rs_ = 0; rs_ < REP_SCAN; ++rs_) { MAKE_L();
          ConvA CV{PROJ, PROJ + SLOT, CA, out + OFF_PCA + (size_t)l * 8 * 2 * DM, out + OFF_SA + (size_t)l * DB * 2 * DM};
          int cv_it = vcu * 512 + tid; asm volatile("" : "+v"(cv_it)); const int cv_stride = G * 512;
          for (int u = vcu; u < 512; u += G) { const int kind = u >> 8, uu = u & 255;
              scan_unit(lds, PROJ + 2 * SLOT, HS, L, out + OFF_PCB + (size_t)l * 8 * 3 * DM, out + OFF_PH + (size_t)l * 8 * DM, out + OFF_SB + (size_t)l * DB * 3 * DM, out + OFF_SH + (size_t)l * DB * DM, kind, uu >> 5, uu & 31, CV, cv_it, cv_stride); }
          for (; cv_it < MT * 128; cv_it += cv_stride) conva_item(CV, L, cv_it); }
        GRID_BAR();
#endif
#if (PHM >> 4) & 1
        { pg8::Gemm g{CA, (const bf16*)(wl + WO_CO), MP, DM, DM}; pg8::StaticOrder S; S.init(MP, DM, G, bx); pg8::EpiBf<1> E{YC, PROJ + 3 * SLOT, nullptr, DM};
          pg8::gemm_phase<pg8::EpiBf<1>, pg8::StaticOrder, true, true>(lds, g, S, E);
          }
        asm volatile("s_waitcnt vmcnt(0)" ::: "memory"); __syncthreads();
#endif
#if (PHM >> 5) & 1
        { pg8::Gemm g{HS, (const bf16*)(wl + WO_RO), MP, DM, DM}; pg8::StaticOrder S; S.init(MP, DM, G, bx); pg8::EpiBf<2> E{Z, PROJ + 4 * SLOT, YC, DM};
          pg8::gemm_phase<pg8::EpiBf<2>, pg8::StaticOrder, true, true>(lds, g, S, E);
          mini_gemm_dual(lds, CA, (const bf16*)(wl + WO_CO), HS, (const bf16*)(wl + WO_RO), PROJ + 3 * SLOT, PROJ + 4 * SLOT, Z, MP, MS, vcu, G); }
        GRID_BAR();
#endif
#if (PHM >> 6) & 1
        { pg8::Gemm g{Z, (const bf16*)(wl + WO_MIX), MP, DM, DM}; pg8::StaticOrder S; S.init(MP, DM, G, bx); pg8::EpiBf<0> E{T, nullptr, nullptr, DM};
          pg8::gemm_phase<pg8::EpiBf<0>, pg8::StaticOrder, true, true>(lds, g, S, E);
          for (int rm_ = 0; rm_ < REP_MINI; ++rm_) mini_gemm<4>(lds, Z, (const bf16*)(wl + WO_MIX), DM, DM, MP, MS, E, vcu, G); }
        GRID_BAR();
#endif
#if (PHM >> 7) & 1
        if (l == 0) row_phase<false, true>(T, ARGIN(0), ARGIN(1), X, gl + 1 * DM, gl + 2 * DM, XN, gw, NGW, lane);
        else row_phase<true, true>(T, X, nullptr, X, gl + 1 * DM, gl + 2 * DM, XN, gw, NGW, lane);
        GRID_BAR();
#endif
#if (PHM >> 8) & 1
        { pg8::Gemm g{XN, (const bf16*)(wl + WO_Q), MP, DM, DM}; pg8::StaticOrder S; S.init(MP, DM, G, bx); pg8::EpiBf<0> E{Qb, nullptr, nullptr, DM};
          pg8::gemm_phase<pg8::EpiBf<0>, pg8::StaticOrder, true, true>(lds, g, S, E);
          for (int rm_ = 0; rm_ < REP_MINI; ++rm_) mini_gemm<4>(lds, XN, (const bf16*)(wl + WO_Q), DM, DM, MP, MS, E, vcu, G); }
        GRID_BAR();
#endif
#if (PHM >> 9) & 1
        for (int ra_ = 0; ra_ < REP_ATTN; ++ra_) {
          const bool sample_first = (vcu & 1) != 0;
          for (int ph = 0; ph < 2; ++ph) {
            if ((ph == 0) != sample_first) { for (int u = vcu; u < 512; u += G) attn_prompt_unit(lds, Qb, MKB + (size_t)l * MROWS * DM, MVT + (size_t)l * MROWS * DM, Ob, u >> 6, (u >> 4) & 3, u & 15); }
            else { const float* ck = ARGIN(5) + (size_t)l * DB * NMEM * DM; const float* cv = ARGIN(6) + (size_t)l * DB * NMEM * DM;
              for (int rs2_ = 0; rs2_ < REP_ATTS; ++rs2_) attn_sample_units(lds, Qb, ck, cv, Ob, vcu, G); }
          } }
        GRID_BAR();
#endif
#if (PHM >> 10) & 1
        { pg8::Gemm g{Ob, (const bf16*)(wl + WO_O), MP, DM, DM}; pg8::StaticOrder S; S.init(MP, DM, G, bx); pg8::EpiBf<0> E{T, nullptr, nullptr, DM};
          pg8::gemm_phase<pg8::EpiBf<0>, pg8::StaticOrder, true, true>(lds, g, S, E);
          for (int rm_ = 0; rm_ < REP_MINI; ++rm_) mini_gemm<4>(lds, Ob, (const bf16*)(wl + WO_O), DM, DM, MP, MS, E, vcu, G); }
        GRID_BAR();
#endif
#if (PHM >> 11) & 1
        row_phase<true, true>(T, X, nullptr, X, gl + 3 * DM, gl + 4 * DM, XN, gw, NGW, lane);
        GRID_BAR();
#endif
#if (PHM >> 12) & 1
        { pg8::Gemm g{XN, (const bf16*)(wl + WO_FI), MT, 2 * DFF, DM}; pg8::StaticOrder S; S.init(MT, 2 * DFF, G, bx); pg8::EpiSwiGLU E{ACT, DFF};
          pg8::gemm_phase<pg8::EpiSwiGLU, pg8::StaticOrder, true, true>(lds, g, S, E); }
        GRID_BAR();
#endif
#if (PHM >> 13) & 1
        { pg8::Gemm g{ACT, (const bf16*)(wl + WO_FO), MP, DM, DFF}; pg8::StaticOrder S; S.init(MP, DM, G, bx); pg8::EpiBf<0> E{T, nullptr, nullptr, DM};
          pg8::gemm_phase<pg8::EpiBf<0>, pg8::StaticOrder, true, true>(lds, g, S, E);
          for (int rm_ = 0; rm_ < REP_MINI; ++rm_) mini_gemm<11>(lds, ACT, (const bf16*)(wl + WO_FO), DFF, DM, MP, MS, E, vcu, G); }
        GRID_BAR();
#endif
#if (PHM >> 14) & 1
        if (l == DEPTH - 1) row_phase<true, false>(T, X, nullptr, out + OFF_Y, gl + 5 * DM, nullptr, nullptr, gw, NGW, lane);
        else row_phase<true, true>(T, X, nullptr, X, gl + 5 * DM, gains + (size_t)(l + 1) * 7 * DM, XN, gw, NGW, lane);
#endif
        if (l != DEPTH - 1) GRID_BAR();
    }
    if (G == 0x7ffffff0) cg::this_grid().sync();
}

#undef tid
#undef lane
#undef wave
#undef G
#undef bx
#undef vcu
#undef gw
#undef NGW
#undef ws
#undef out
#undef XN
#undef MN
#undef PROJ
#undef CA
#undef HS
#undef YC
#undef Z
#undef T
#undef X
#undef Qb
#undef Ob
#undef ACT
#undef MKB
#undef MVT
#undef gains
#undef wl
#undef gl
extern "C" void kernel_launch(void* const* d_in, const int* in_sizes, int n_in, void* d_out, int out_size, void* d_ws, size_t ws_size, hipStream_t stream) {
    static int grid = 0;
    if (grid == 0) {
        if (n_in != 26 || (size_t)out_size != OUT_TOTAL || ws_size < WS_END) { fprintf(stderr, "kernel_launch: unexpected shapes: n_in %d out %d ws %zu\n", n_in, out_size, ws_size); grid = -1; return; }
        int dev = 0, cus = 0, per_cu = 0;
        if (hipGetDevice(&dev) != hipSuccess || hipDeviceGetAttribute(&cus, hipDeviceAttributeMultiprocessorCount, dev) != hipSuccess) { grid = -1; return; }
        if (hipFuncSetAttribute((const void*)fwd_megakernel, hipFuncAttributeMaxDynamicSharedMemorySize, LDS_BYTES) != hipSuccess) { fprintf(stderr, "kernel_launch: hipFuncSetAttribute failed\n"); grid = -1; return; }
        if (hipOccupancyMaxActiveBlocksPerMultiprocessor(&per_cu, (const void*)fwd_megakernel, NWAVES * 64, LDS_BYTES) != hipSuccess || per_cu < 1) { fprintf(stderr, "kernel_launch: occupancy query says %d\n", per_cu); per_cu = 1; }
        (void)hipGetLastError();
        grid = cus;
    }
    if (grid < 0) return;
    (void)hipMemsetAsync((char*)d_ws + WS_CTL, 0, CTL_ZERO_BYTES, stream);
    Args a{};
    for (int i = 0; i < 26; ++i) a.in[i] = (const float*)d_in[i];
    a.out = (float*)d_out; a.ws = (unsigned char*)d_ws;
    void* kargs[] = {&a};
    hipError_t e = hipLaunchCooperativeKernel((const void*)fwd_megakernel, dim3(grid), dim3(NWAVES * 64), kargs, LDS_BYTES, stream);
    if (e != hipSuccess) fprintf(stderr, "kernel_launch: cooperative launch failed: %s (grid %d)\n", hipGetErrorString(e), grid);
}
```

```cpp
#include <hip/hip_runtime.h>
#include <hip/hip_cooperative_groups.h>
#include <cstdio>
#include <cstdint>
namespace cg = cooperative_groups;
#ifndef PHM
#define PHM 0xFFFFFF
#endif
#define CONVA_INTERLEAVE 1
#define REP_S1 1
#define REP_S2 1
#define REP_S3 1
#define REP_PRO 1
#define REP_ATTS 1
#define REP_ROW 1
#define REP_SCAN 1
#define REP_ATTN 1
#define REP_BAR 1
#define REP_MINI 1
namespace pg8 {
#define PG8_LAS __attribute__((address_space(3)))
typedef unsigned short bf16_t;
typedef short bf16x8 __attribute__((ext_vector_type(8)));
typedef float f32x4 __attribute__((ext_vector_type(4)));
typedef unsigned u32x4 __attribute__((ext_vector_type(4)));
constexpr int BM = 256, BK = 64, HALF = 128, HTB = HALF * BK * 2  , STAGE_BYTES = 8 * HTB, NXCD = 8, WGM = 4;

__host__ __device__ __forceinline__ int lds_byte(int r, int c) { const int st = (r >> 4) * 2 + (c >> 5), rr = r & 15, cc = c & 31, ob = rr * 64 + cc * 2; return st * 1024 + (ob ^ (((ob >> 9) & 1) << 5)); }
__host__ __device__ __forceinline__ void stage_rc(int b, int& R, int& C) { const int st = b / 1024, sb = b % 1024, swz = sb ^ (((sb >> 9) & 1) << 5); R = (st >> 1) * 16 + swz / 64; C = (st & 1) * 32 + (swz % 64) / 2; }
__host__ __device__ __forceinline__ int perm32(int rho) { const int n = rho >> 4, i = rho & 15; return 8 * (i >> 2) + 4 * n + (i & 3); }

struct Unit { int pm, pn; };
struct Gemm { const bf16_t* A; const bf16_t* Bt; int M, N, K; };

struct StaticOrder {
    int nM, nN, nwg, G, c;
    __host__ __device__ void init(int M, int N, int G_, int c_) { nM = M / BM; nN = N / BM; nwg = nM * nN; G = G_; c = c_; }
    __host__ __device__ bool next(int i, Unit& u) const {
        const long L = (long)i * G + c; if (L >= nwg) return false;
        int wgid = (int)L; { const int q = nwg / NXCD, r = nwg % NXCD, xcd = wgid % NXCD, off = wgid / NXCD; wgid = (xcd < r ? xcd * (q + 1) : r * (q + 1) + (xcd - r) * q) + off; }
        const int nig = WGM * nN, gid = wgid / nig, fm = gid * WGM, gsz = (nM - fm) < WGM ? (nM - fm) : WGM;
        u.pm = fm + ((wgid % nig) % gsz); u.pn = (wgid % nig) / gsz; return true;
    }
    __device__ __forceinline__ void a_ready(const Unit&) const {}
    __device__ __forceinline__ void done(const Unit&) const {}
};

typedef float f32x2_t __attribute__((ext_vector_type(2))); typedef __bf16 bf16x2_t __attribute__((ext_vector_type(2)));
__device__ __forceinline__ unsigned cvt_pk_bf16(float lo, float hi) { f32x2_t v = {lo, hi}; bf16x2_t b = __builtin_convertvector(v, bf16x2_t); return __builtin_bit_cast(unsigned, b); }
typedef unsigned u32x2 __attribute__((ext_vector_type(2)));
__device__ __forceinline__ float bflo(unsigned w) { return __uint_as_float(w << 16); }
__device__ __forceinline__ float bfhi(unsigned w) { return __uint_as_float(w & 0xffff0000u); }
__device__ __forceinline__ float sigmoidf_(float x) { return __builtin_amdgcn_rcpf(1.0f + __expf(-x)); }
__device__ __forceinline__ void st_bf16x4(bf16_t* p, f32x4 v) { u32x2 w; w.x = cvt_pk_bf16(v[0], v[1]); w.y = cvt_pk_bf16(v[2], v[3]); *(u32x2*)p = w; }
__device__ __forceinline__ f32x4 ld_bf16x4(const bf16_t* p) { const u32x2 w = *(const u32x2*)p; return (f32x4){bflo(w.x), bfhi(w.x), bflo(w.y), bfhi(w.y)}; }

typedef unsigned u32x4e __attribute__((ext_vector_type(4)));
__device__ __forceinline__ void st_bf16x8(bf16_t* p, f32x4 a, f32x4 b) { u32x4e w; w.x = cvt_pk_bf16(a[0], a[1]); w.y = cvt_pk_bf16(a[2], a[3]); w.z = cvt_pk_bf16(b[0], b[1]); w.w = cvt_pk_bf16(b[2], b[3]); *(u32x4e*)p = w; }
__device__ __forceinline__ void ld_bf16x8(const bf16_t* p, f32x4& a, f32x4& b) { const u32x4e w = *(const u32x4e*)p; a = (f32x4){bflo(w.x), bfhi(w.x), bflo(w.y), bfhi(w.y)}; b = (f32x4){bflo(w.z), bfhi(w.z), bflo(w.w), bfhi(w.w)}; }
template <int MODE> struct EpiBf {
    static constexpr bool PERM = true, AFTER_DRAIN = false;
    bf16_t* O; const bf16_t* mul; const bf16_t* add; int ldc;
    __device__ __forceinline__ void apply(int row, int col, f32x4 v) const { const size_t o = (size_t)row * ldc + col;
        if (MODE >= 1) v = v * ld_bf16x4(mul + o);
        if (MODE == 2) v = v + ld_bf16x4(add + o);
        st_bf16x4(O + o, v); }
    __device__ __forceinline__ void operator()(const f32x4 (&acc)[2][2][4][2], const Unit& u, int wr, int wc, int fr, int fq) const {
        const int row0 = u.pm * BM + wr * 64 + fr, col0 = u.pn * BM + wc * 32 + 8 * fq;
#pragma unroll
        for (int ai = 0; ai < 2; ++ai) {
            u32x4e gm[4][2], ga[4][2];
            if (MODE >= 1) {
#pragma unroll
                for (int m = 0; m < 4; ++m)
#pragma unroll
                    for (int bj = 0; bj < 2; ++bj) { const size_t o = (size_t)(row0 + ai * HALF + m * 16) * ldc + col0 + bj * HALF; gm[m][bj] = __builtin_nontemporal_load((const u32x4e*)(mul + o)); if (MODE == 2) ga[m][bj] = __builtin_nontemporal_load((const u32x4e*)(add + o)); } }
#pragma unroll
            for (int m = 0; m < 4; ++m) { const size_t ro = (size_t)(row0 + ai * HALF + m * 16) * ldc + col0;
#pragma unroll
                for (int bj = 0; bj < 2; ++bj) { const size_t o = ro + bj * HALF; f32x4 v0 = acc[ai][bj][m][0], v1 = acc[ai][bj][m][1];
                        if (MODE >= 1) { const u32x4e w = gm[m][bj]; v0 = v0 * (f32x4){bflo(w.x), bfhi(w.x), bflo(w.y), bfhi(w.y)}; v1 = v1 * (f32x4){bflo(w.z), bfhi(w.z), bflo(w.w), bfhi(w.w)}; }
                        if (MODE == 2) { const u32x4e w = ga[m][bj]; v0 = v0 + (f32x4){bflo(w.x), bfhi(w.x), bflo(w.y), bfhi(w.y)}; v1 = v1 + (f32x4){bflo(w.z), bfhi(w.z), bflo(w.w), bfhi(w.w)}; }
                        st_bf16x8(O + o, v0, v1); } }
            if (MODE >= 1) asm volatile("" ::: "memory"); }
    }
};
struct EpiF32 {
    static constexpr bool PERM = false, AFTER_DRAIN = false;
    float* O; int ldc;
    __device__ __forceinline__ void apply(int row, int col, f32x4 v) const { *(f32x4*)(O + (size_t)row * ldc + col) = v; }
    __device__ __forceinline__ void operator()(const f32x4 (&acc)[2][2][4][2], const Unit& u, int wr, int wc, int fr, int fq) const {
        const int row0 = u.pm * BM + wr * 64 + fr, col0 = u.pn * BM + wc * 32 + 4 * fq;
#pragma unroll
        for (int ai = 0; ai < 2; ++ai)
#pragma unroll
            for (int m = 0; m < 4; ++m) { const size_t ro = (size_t)(row0 + ai * HALF + m * 16) * ldc + col0;
#pragma unroll
                for (int bj = 0; bj < 2; ++bj)
#pragma unroll
                    for (int n = 0; n < 2; ++n) *(f32x4*)(O + ro + bj * HALF + n * 16) = acc[ai][bj][m][n]; }
    }
};
struct EpiInProj {
    static constexpr bool PERM = true, AFTER_DRAIN = false;
    bf16_t* P; size_t slot;
    __device__ __forceinline__ void operator()(const f32x4 (&acc)[2][2][4][2], const Unit& u, int wr, int wc, int fr, int fq) const {
        const int row0 = u.pm * BM + wr * 64 + fr; const int pn = u.pn;
        if (pn >= 4 && pn < 12) {
            bf16_t* base = P + slot; const int col0 = (pn - 4) * HALF + wc * 32 + 8 * fq;
#pragma unroll
            for (int ai = 0; ai < 2; ++ai)
#pragma unroll
                for (int m = 0; m < 4; ++m) { const size_t ro = (size_t)(row0 + ai * HALF + m * 16) * 1024 + col0;
                    st_bf16x8(base + ro, acc[ai][0][m][0] * acc[ai][1][m][0], acc[ai][0][m][1] * acc[ai][1][m][1]); }
        } else {
            int s, ct; if (pn < 4) { s = 0; ct = pn; } else if (pn < 16) { s = 2; ct = pn - 12; } else if (pn < 20) { s = 3; ct = pn - 16; } else { s = 4; ct = pn - 20; }
            bf16_t* base = P + (size_t)s * slot; const int col0 = ct * BM + wc * 32 + 8 * fq; const bool sg = (s >= 3);
#pragma unroll
            for (int ai = 0; ai < 2; ++ai)
#pragma unroll
                for (int m = 0; m < 4; ++m) { const size_t ro = (size_t)(row0 + ai * HALF + m * 16) * 1024 + col0;
#pragma unroll
                    for (int bj = 0; bj < 2; ++bj) { f32x4 v0 = acc[ai][bj][m][0], v1 = acc[ai][bj][m][1];
                            if (sg) {
#pragma unroll
                                for (int i = 0; i < 4; ++i) { v0[i] = sigmoidf_(v0[i]); v1[i] = sigmoidf_(v1[i]); } }
                            st_bf16x8(base + ro + bj * HALF, v0, v1); } }
        }
    }
};
struct EpiSwiGLU {
    static constexpr bool PERM = true, AFTER_DRAIN = false;
    bf16_t* O; int ldc;
    __device__ __forceinline__ void operator()(const f32x4 (&acc)[2][2][4][2], const Unit& u, int wr, int wc, int fr, int fq) const {
        const int row0 = u.pm * BM + wr * 64 + fr, col0 = u.pn * HALF + wc * 32 + 8 * fq;
#pragma unroll
        for (int ai = 0; ai < 2; ++ai)
#pragma unroll
            for (int m = 0; m < 4; ++m) { const size_t ro = (size_t)(row0 + ai * HALF + m * 16) * ldc + col0; f32x4 v[2];
#pragma unroll
                for (int n = 0; n < 2; ++n) { const f32x4 g = acc[ai][0][m][n], up = acc[ai][1][m][n];
#pragma unroll
                    for (int i = 0; i < 4; ++i) v[n][i] = g[i] * sigmoidf_(g[i]) * up[i]; }
                st_bf16x8(O + ro, v[0], v[1]); }
    }
};
struct EpiMemKV {
    static constexpr bool PERM = false, AFTER_DRAIN = false;
    float* outK; float* outV; bf16_t* KB; bf16_t* VT;
    __device__ __forceinline__ void operator()(const f32x4 (&acc)[2][2][4][2], const Unit& u, int wr, int wc, int fr, int fq) const {
        const int row0 = u.pm * BM + wr * 64 + fr; const bool isv = (u.pn >= 4); const int col0 = (u.pn & 3) * BM + wc * 32 + 4 * fq;
        float* of = isv ? outV : outK;
#pragma unroll
        for (int ai = 0; ai < 2; ++ai)
#pragma unroll
            for (int m = 0; m < 4; ++m) { const int row = row0 + ai * HALF + m * 16; const size_t ro = (size_t)row * 1024 + col0;
#pragma unroll
                for (int bj = 0; bj < 2; ++bj)
#pragma unroll
                    for (int n = 0; n < 2; ++n) { const f32x4 v = acc[ai][bj][m][n]; const size_t o = ro + bj * HALF + n * 16;
                        __builtin_nontemporal_store(v, (f32x4*)(of + o));
                        if (!isv) st_bf16x4(KB + o, v);
                        else { const int c = col0 + bj * HALF + n * 16; const int b = row >> 8, mm = row & 255;
                            bf16_t* vt = VT + ((size_t)(b * 1024 + c)) * 256 + mm;
                            const unsigned w0 = cvt_pk_bf16(v[0], v[1]), w1 = cvt_pk_bf16(v[2], v[3]);
                            vt[0] = (bf16_t)(w0 & 0xffffu); vt[256] = (bf16_t)(w0 >> 16); vt[512] = (bf16_t)(w1 & 0xffffu); vt[768] = (bf16_t)(w1 >> 16); } } }
    }
};

template <class Epi, class Sched, bool ALIGN_EPI = false, bool SP2 = false>
__device__ __forceinline__ void gemm_phase(PG8_LAS unsigned char* lds, const Gemm g, const Sched& S, const Epi& E) {
    int tid_o = threadIdx.x; asm volatile("" : "+v"(tid_o));
    const int tid = tid_o, wid = __builtin_amdgcn_readfirstlane(tid >> 6), lane = tid & 63, wr = wid >> 2, wc = wid & 3, fr = lane & 15, fq = lane >> 4;
    const int K = g.K, nt = K / BK;
    unsigned voffA[2], voffB[2];
#pragma unroll
    for (int i = 0; i < 2; ++i) { int R, C; stage_rc(tid * 16 + i * 8192, R, C); const int Rb = Epi::PERM ? ((R & ~31) + perm32(R & 31)) : R;
        voffA[i] = (unsigned)(R * K + C) * 2u; voffB[i] = (unsigned)(Rb * K + C) * 2u; }
    const size_t kstep = (size_t)(BK * 2);
    const size_t hstep = (size_t)HALF * K * 2;
    const size_t tstep = 2 * hstep;
    const unsigned ldsw = (unsigned)wid * 1024u;
    const int aoff = lds_byte(wr * 64 + fr, fq * 8), boff = lds_byte(wc * 32 + fr, fq * 8);
#define PG8_SA(b, h) (((b) * 2 + (h)) * HTB)
#define PG8_SB(b, h) ((4 + (b) * 2 + (h)) * HTB)
#define PG8_STAGE(bufoff, gbase, voff) do { _Pragma("unroll") for (int _i = 0; _i < 2; ++_i) \
        __builtin_amdgcn_global_load_lds((const unsigned*)((const char*)(gbase) + (voff)[_i]), (PG8_LAS unsigned*)(lds + (bufoff) + ldsw + _i * 8192), 16, 0, 0); } while (0)
#define PG8_LDA(dst, b, h) do { _Pragma("unroll") for (int m = 0; m < 4; ++m) _Pragma("unroll") for (int k = 0; k < 2; ++k) dst[m][k] = *(const PG8_LAS bf16x8*)(lds + PG8_SA(b, h) + aoff + m * 2048 + k * 1024); } while (0)
#define PG8_LDB(dst, b, h) do { _Pragma("unroll") for (int n = 0; n < 2; ++n) _Pragma("unroll") for (int k = 0; k < 2; ++k) dst[n][k] = *(const PG8_LAS bf16x8*)(lds + PG8_SB(b, h) + boff + n * 2048 + k * 1024); } while (0)
#define PG8_MMA(ai, bj, At, Bt) do { __builtin_amdgcn_s_setprio(1); _Pragma("unroll") for (int m = 0; m < 4; ++m) _Pragma("unroll") for (int n = 0; n < 2; ++n) _Pragma("unroll") for (int k = 0; k < 2; ++k) \
        acc[ai][bj][m][n] = __builtin_amdgcn_mfma_f32_16x16x32_bf16(Bt[n][k], At[m][k], acc[ai][bj][m][n], 0, 0, 0); __builtin_amdgcn_s_setprio(0); } while (0)
#define PG8_WAIT_V(n) asm volatile("s_waitcnt vmcnt(" #n ")" ::: "memory")
#define PG8_WAIT_L(n) asm volatile("s_waitcnt lgkmcnt(" #n ")" ::: "memory")
#define PG8_BAR __builtin_amdgcn_s_barrier()
#define PG8_SCHED __builtin_amdgcn_sched_barrier(0)
    Unit cur, nxt; int ui = 0;
    if (!S.next(0, cur)) return;
    f32x4 acc[2][2][4][2];
#pragma unroll
    for (int a = 0; a < 2; ++a)
#pragma unroll
        for (int b = 0; b < 2; ++b)
#pragma unroll
            for (int m = 0; m < 4; ++m)
#pragma unroll
                for (int n = 0; n < 2; ++n) acc[a][b][m][n] = (f32x4){0.f, 0.f, 0.f, 0.f};
    bf16x8 At[4][2], B0[2][2], B1[2][2];
    const char* cA = (const char*)g.A + (size_t)cur.pm * tstep; const char* cB = (const char*)g.Bt + (size_t)cur.pn * tstep;
    S.a_ready(cur);
    if constexpr (SP2) {
        PG8_STAGE(PG8_SB(0, 0), cB, voffB); PG8_STAGE(PG8_SB(0, 1), cB + hstep, voffB); PG8_STAGE(PG8_SA(0, 0), cA, voffA); PG8_STAGE(PG8_SA(0, 1), cA + hstep, voffA);
        if (wr == 1) PG8_BAR;
        PG8_WAIT_V(2); PG8_BAR;
        PG8_STAGE(PG8_SB(1, 0), cB + kstep, voffB); PG8_STAGE(PG8_SA(1, 0), cA + kstep, voffA); PG8_STAGE(PG8_SB(1, 1), cB + hstep + kstep, voffB);
        PG8_WAIT_V(6); PG8_BAR;
    } else {
        PG8_STAGE(PG8_SB(0, 0), cB, voffB); PG8_STAGE(PG8_SA(0, 0), cA, voffA); PG8_STAGE(PG8_SB(0, 1), cB + hstep, voffB); PG8_STAGE(PG8_SA(0, 1), cA + hstep, voffA);
        if (wr == 1) PG8_BAR;
        PG8_WAIT_V(4); PG8_BAR;
        PG8_STAGE(PG8_SB(1, 0), cB + kstep, voffB); PG8_STAGE(PG8_SA(1, 0), cA + kstep, voffA); PG8_STAGE(PG8_SB(1, 1), cB + hstep + kstep, voffB);
        PG8_WAIT_V(6); PG8_BAR;
    }
    for (;;) {
        const bool has_next = S.next(ui + 1, nxt);
        const char* nA = has_next ? (const char*)g.A + (size_t)nxt.pm * tstep : cA; const char* nB = has_next ? (const char*)g.Bt + (size_t)nxt.pn * tstep : cB;
        for (int t = 0; t < nt; t += 2) {
            const bool last = (t == nt - 2);
            const char* a1 = cA + (size_t)(t + 1) * kstep;
            const char* a2 = last ? nA : cA + (size_t)(t + 2) * kstep; const char* b2 = last ? nB : cB + (size_t)(t + 2) * kstep;
            const char* a3 = a2 + kstep; const char* b3 = b2 + kstep;
            if (last && has_next) S.a_ready(nxt);
            if constexpr (SP2) {
            PG8_LDB(B0, 0, 0); PG8_LDB(B1, 0, 1); PG8_SCHED; PG8_LDA(At, 0, 0); PG8_STAGE(PG8_SA(1, 1), a1 + hstep, voffA);
            PG8_WAIT_V(8); PG8_WAIT_L(0); PG8_BAR; PG8_MMA(0, 0, At, B0); PG8_MMA(0, 1, At, B1); PG8_BAR; PG8_SCHED;
            PG8_LDA(At, 0, 1); PG8_STAGE(PG8_SB(0, 0), b2, voffB); PG8_STAGE(PG8_SB(0, 1), b2 + hstep, voffB); PG8_STAGE(PG8_SA(0, 0), a2, voffA);
            PG8_WAIT_V(8); PG8_WAIT_L(0); PG8_BAR; PG8_MMA(1, 0, At, B0); PG8_MMA(1, 1, At, B1); PG8_BAR; PG8_SCHED;
            PG8_LDB(B0, 1, 0); PG8_LDB(B1, 1, 1); PG8_SCHED; PG8_LDA(At, 1, 0); PG8_STAGE(PG8_SA(0, 1), a2 + hstep, voffA);
            PG8_WAIT_V(8); PG8_WAIT_L(0); PG8_BAR; PG8_MMA(0, 0, At, B0); PG8_MMA(0, 1, At, B1); PG8_BAR; PG8_SCHED;
            PG8_LDA(At, 1, 1); PG8_STAGE(PG8_SB(1, 0), b3, voffB); PG8_STAGE(PG8_SB(1, 1), b3 + hstep, voffB); PG8_STAGE(PG8_SA(1, 0), a3, voffA);
            PG8_WAIT_V(8); PG8_WAIT_L(0); PG8_BAR; PG8_MMA(1, 0, At, B0); PG8_MMA(1, 1, At, B1); PG8_BAR; PG8_SCHED;
            } else {
            PG8_LDB(B0, 0, 0); PG8_SCHED; PG8_LDA(At, 0, 0); PG8_STAGE(PG8_SA(1, 1), a1 + hstep, voffA);
            PG8_WAIT_L(8); PG8_BAR; PG8_WAIT_L(0); PG8_MMA(0, 0, At, B0); PG8_BAR; PG8_SCHED;
            PG8_LDB(B1, 0, 1); PG8_STAGE(PG8_SB(0, 0), b2, voffB);
            PG8_BAR; PG8_WAIT_L(0); PG8_MMA(0, 1, At, B1); PG8_BAR;
            PG8_LDA(At, 0, 1); PG8_STAGE(PG8_SA(0, 0), a2, voffA);
            PG8_BAR; PG8_WAIT_L(0); PG8_MMA(1, 0, At, B0); PG8_BAR; PG8_SCHED;
            PG8_STAGE(PG8_SB(0, 1), b2 + hstep, voffB);
            PG8_WAIT_V(6); PG8_BAR; PG8_MMA(1, 1, At, B1); PG8_BAR;
            PG8_LDB(B0, 1, 0); PG8_SCHED; PG8_LDA(At, 1, 0); PG8_STAGE(PG8_SA(0, 1), a2 + hstep, voffA);
            PG8_WAIT_L(8); PG8_BAR; PG8_WAIT_L(0); PG8_MMA(0, 0, At, B0); PG8_BAR; PG8_SCHED;
            PG8_LDB(B1, 1, 1); PG8_STAGE(PG8_SB(1, 0), b3, voffB);
            PG8_BAR; PG8_WAIT_L(0); PG8_MMA(0, 1, At, B1); PG8_BAR;
            PG8_LDA(At, 1, 1); PG8_STAGE(PG8_SA(1, 0), a3, voffA);
            PG8_BAR; PG8_WAIT_L(0); PG8_MMA(1, 0, At, B0); PG8_BAR; PG8_SCHED;
            PG8_STAGE(PG8_SB(1, 1), b3 + hstep, voffB);
            PG8_WAIT_V(6); PG8_BAR; PG8_MMA(1, 1, At, B1); PG8_BAR;
            }
        }
        if constexpr (ALIGN_EPI) { if (wr == 0) PG8_BAR; }
        if constexpr (!Epi::AFTER_DRAIN) { E(acc, cur, wr, wc, fr, fq); S.done(cur); }
        if (!has_next) break;
#pragma unroll
        for (int a = 0; a < 2; ++a)
#pragma unroll
            for (int b = 0; b < 2; ++b)
#pragma unroll
                for (int m = 0; m < 4; ++m)
#pragma unroll
                    for (int n = 0; n < 2; ++n) acc[a][b][m][n] = (f32x4){0.f, 0.f, 0.f, 0.f};
        cur = nxt; cA = nA; cB = nB; ++ui;
        if constexpr (ALIGN_EPI) { if (wr == 1) PG8_BAR; }
    }
    PG8_WAIT_V(0);
    if constexpr (!ALIGN_EPI) { if (wr == 0) PG8_BAR; }
    PG8_BAR;
    if constexpr (Epi::AFTER_DRAIN) { E.fused(acc, cur, wr, wc, fr, fq, lds, wid, lane); S.done(cur); }
#undef PG8_SA
#undef PG8_SB
#undef PG8_STAGE
#undef PG8_LDA
#undef PG8_LDB
#undef PG8_MMA
#undef PG8_WAIT_V
#undef PG8_WAIT_L
#undef PG8_BAR
#undef PG8_SCHED
}
}

constexpr int NWAVES = 8;
constexpr int DM = 1024, NB = 8, SEQ = 2048, DEPTH = 2, DB = 128, DSEQ = 8, NMEM = 256, NH = 4, HD = 256, DFF = 2816, DIN = 6144;
constexpr int MP = NB * SEQ, MS = DB * DSEQ, MT = MP + MS;
constexpr int MROWS = NB * NMEM;
constexpr float EPS = 1e-6f;
constexpr size_t MiB = 1u << 20;
constexpr size_t WS_CTL = 0, CTL_ZERO_BYTES = 64 * 1024;
constexpr size_t WS_W = 2 * MiB, W_LAYER = 44 * MiB;
constexpr size_t WO_IN = 0, WO_CO = 12 * MiB, WO_RO = 14 * MiB, WO_MIX = 16 * MiB, WO_KV = 18 * MiB, WO_Q = 22 * MiB, WO_O = 24 * MiB, WO_FI = 26 * MiB, WO_FO = 37 * MiB;
constexpr size_t WS_XN = 92 * MiB;
constexpr size_t WS_MN = 128 * MiB;
constexpr size_t WS_PROJ = 138 * MiB;
constexpr size_t WS_CA = 310 * MiB, WS_HS = 346 * MiB, WS_YC = 382 * MiB, WS_Z = 418 * MiB;
constexpr size_t WS_T = 454 * MiB, WS_X = 524 * MiB;
constexpr size_t WS_Q = 594 * MiB, WS_O = 630 * MiB;
constexpr size_t WS_ACT = 666 * MiB;
constexpr size_t WS_MKB = 762 * MiB, WS_MVT = 772 * MiB;
constexpr size_t WS_END = 782 * MiB;
constexpr size_t SLOT = (size_t)MT * DM;
constexpr size_t OFF_Y = 0, OFF_PCA = (size_t)MT * DM, OFF_PCB = OFF_PCA + 2 * 8 * 2 * 1024, OFF_PH = OFF_PCB + 2 * 8 * 3 * 1024, OFF_PK = OFF_PH + 2 * 8 * 1024,
                 OFF_PV = OFF_PK + (size_t)2 * MROWS * DM, OFF_SA = OFF_PV + (size_t)2 * MROWS * DM, OFF_SB = OFF_SA + 2 * 128 * 2 * 1024, OFF_SH = OFF_SB + 2 * 128 * 3 * 1024,
                 OUT_TOTAL = OFF_SH + 2 * 128 * 1024;
constexpr int CW_BAR = 1024;
constexpr int LDS_BYTES = 147456;
constexpr int MISC_OFF = 146432;

#define GAS __attribute__((address_space(1)))
#define LAS __attribute__((address_space(3)))
typedef unsigned short bf16;
typedef unsigned v4u __attribute__((ext_vector_type(4)));
typedef unsigned v2u __attribute__((ext_vector_type(2)));
typedef float f32x4 __attribute__((ext_vector_type(4)));
typedef short bf16x8 __attribute__((ext_vector_type(8)));
#define LDS_WAIT() asm volatile("s_waitcnt lgkmcnt(0)" ::: "memory")
using pg8::cvt_pk_bf16; using pg8::bflo; using pg8::bfhi; using pg8::sigmoidf_;
__device__ __forceinline__ float wave_sum(float v) {
#pragma unroll
    for (int o = 1; o < 64; o <<= 1) v += __shfl_xor(v, o);
    return v;
}
#define XB_TMO      128
#define XB_XCNT(j)  (256  + 64 * (j))
#define XB_XSUB(j)  (1280 + 64 * (j))
#define XB_XGEN(j)  (2304 + 64 * (j))
#define XB_TOP      3328
#define XB_TOPGEN   3392
#define XCD_BAR_WORDS 3456
#define XB_SPIN_CAP (1u << 18)

__device__ __forceinline__ unsigned xb_ld(unsigned* p)              { return __hip_atomic_load(p, __ATOMIC_RELAXED, __HIP_MEMORY_SCOPE_AGENT); }
__device__ __forceinline__ unsigned xb_add(unsigned* p, unsigned v) { return __hip_atomic_fetch_add(p, v, __ATOMIC_RELAXED, __HIP_MEMORY_SCOPE_AGENT); }
__device__ __forceinline__ unsigned xb_xcc_id() { return (unsigned)__builtin_amdgcn_s_getreg((3 << 11) | 20) & 0xFu; }
#define XB_SPIN(cond, bar) do { unsigned _sp = 0; while (cond) { __builtin_amdgcn_s_sleep(1); \
    if ((++_sp & 255u) == 0u) { if (xb_ld(&(bar)[XB_TMO])) break; if (_sp > XB_SPIN_CAP) { atomicAdd(&(bar)[XB_TMO], 1u); break; } } } } while (0)

struct XcdBarrier {
    unsigned* bar; unsigned x;
    volatile LAS unsigned* st;
};

__device__ __forceinline__ XcdBarrier xcd_barrier_post(unsigned* bar, volatile LAS unsigned* st) {
    XcdBarrier b; b.bar = bar; b.x = xb_xcc_id(); b.st = st;
    if (threadIdx.x == 0) (void)xb_add(&bar[XB_XCNT(b.x)], 1u);
    return b;
}
__device__ __forceinline__ void xcd_barrier_complete(unsigned* bar, unsigned x, unsigned& nloc, unsigned& nx) {
    const unsigned G = gridDim.x * gridDim.y * gridDim.z;
    unsigned sum, cnt, mine, sp = 0u;
    for (;;) {
        sum = 0u; cnt = 0u; mine = 0u;
#pragma unroll
        for (unsigned j = 0; j < 16; ++j) { const unsigned c = xb_ld(&bar[XB_XCNT(j)]); sum += c; cnt += (c > 0u) ? 1u : 0u; mine = (j == x) ? c : mine; }
        if (sum == G) break;
        __builtin_amdgcn_s_sleep(1);
        if ((++sp & 255u) == 0u) { if (xb_ld(&bar[XB_TMO])) break; if (sp > XB_SPIN_CAP) { atomicAdd(&bar[XB_TMO], 1u); break; } }
    }
    nloc = mine > 0u ? mine : 1u; nx = cnt > 0u ? cnt : 1u;
}

__device__ __forceinline__ void xcd_barrier(const XcdBarrier& b) {
    asm volatile("s_waitcnt vmcnt(0)" ::: "memory");
    __syncthreads();
    if (threadIdx.x == 0) {
        unsigned* bar = b.bar;
        __builtin_amdgcn_s_waitcnt(0);
        unsigned nloc = b.st[0], nx = b.st[1];
        if (nloc == 0u) { xcd_barrier_complete(bar, b.x, nloc, nx); b.st[0] = nloc; b.st[1] = nx; }
        const unsigned old = xb_add(&bar[XB_XSUB(b.x)], 1u);
        const unsigned gen = old / nloc;
        if (old + 1u == (gen + 1u) * nloc) {
            __builtin_amdgcn_fence(__ATOMIC_RELEASE, "agent");
            asm volatile("s_waitcnt vmcnt(0)" ::: "memory");
            const unsigned og = xb_add(&bar[XB_TOP], 1u);
            const unsigned tg = og / nx;
            if (og + 1u == (tg + 1u) * nx) xb_add(&bar[XB_TOPGEN], 1u);
            else XB_SPIN(xb_ld(&bar[XB_TOPGEN]) == tg, bar);
            __builtin_amdgcn_fence(__ATOMIC_ACQUIRE, "agent");
            xb_add(&bar[XB_XGEN(b.x)], 1u);
            asm volatile("s_waitcnt vmcnt(0)" ::: "memory");
        } else {
            XB_SPIN(xb_ld(&bar[XB_XGEN(b.x)]) == gen, bar);
            __builtin_amdgcn_fence(__ATOMIC_ACQUIRE, "agent");
            asm volatile("s_waitcnt vmcnt(0)" ::: "memory");
        }
    }
    __syncthreads();
}

__device__ __forceinline__ int map_row(int mapid, int n) {
    if (mapid == 1) { const int seg = n >> 10, c = n & 1023;
        if (seg == 0) return c; if (seg == 1) return 1024 + (c >> 7) * 256 + (c & 127); if (seg == 2) return 1024 + (c >> 7) * 256 + 128 + (c & 127);
        return 3072 + (seg - 3) * 1024 + c; }
    if (mapid == 2) { if (n < DFF) return (n >> 7) * 256 + (n & 127); const int c = n - DFF; return (c >> 7) * 256 + 128 + (c & 127); }
    return n;
}
__device__ __forceinline__ void transpose_item(const float* W, int K, int N, bf16* WT, int mapid, LAS float* scr, int item, int lane) {
    const int nblk = N / 32, kb = item / nblk, nb = item % nblk, k0 = 64 * kb, n0 = 32 * nb;
#pragma unroll 8
    for (int i = 0; i < 32; ++i) { const int kk = 2 * i + (lane >> 5); scr[kk * 33 + (lane & 31)] = __builtin_nontemporal_load(W + (size_t)(k0 + kk) * N + n0 + (lane & 31)); }
    LDS_WAIT(); asm volatile("" ::: "memory");
    const int c = lane & 7; const int r0 = map_row(mapid, n0);
#pragma unroll
    for (int j = 0; j < 4; ++j) { const int n = (lane >> 3) + 8 * j; const LAS float* s = scr + (8 * c) * 33 + n;
        v4u o; o.x = cvt_pk_bf16(s[0 * 33], s[1 * 33]); o.y = cvt_pk_bf16(s[2 * 33], s[3 * 33]); o.z = cvt_pk_bf16(s[4 * 33], s[5 * 33]); o.w = cvt_pk_bf16(s[6 * 33], s[7 * 33]);
        *(v4u*)(WT + (size_t)(r0 + n) * K + k0 + 8 * c) = o; }
    LDS_WAIT(); asm volatile("" ::: "memory");
}
__device__ __forceinline__ void rms_row_to_bf16(const float* xrow, const float* g, bf16* orow, int lane) {
    const f32x4* xr = (const f32x4*)xrow + lane; const f32x4* gr = (const f32x4*)g + lane;
    f32x4 v[4]; float s = 0.f;
#pragma unroll
    for (int j = 0; j < 4; ++j) { v[j] = __builtin_nontemporal_load(xr + 64 * j); s += (v[j].x * v[j].x + v[j].y * v[j].y) + (v[j].z * v[j].z + v[j].w * v[j].w); }
    const float rs = 1.0f / sqrtf(wave_sum(s) * (1.f / DM) + EPS);
    v2u* o8 = (v2u*)orow + lane;
#pragma unroll
    for (int j = 0; j < 4; ++j) { const f32x4 gg = gr[64 * j]; v2u w; w.x = cvt_pk_bf16(v[j].x * rs * gg.x, v[j].y * rs * gg.y); w.y = cvt_pk_bf16(v[j].z * rs * gg.z, v[j].w * rs * gg.w); o8[64 * j] = w; }
}
template <bool XIN_BF, bool XOUT_BF> __device__ __forceinline__ void row_phase(const bf16* T, const void* xinA, const void* xinB, void* xout, const float* gpost, const float* gpre, bf16* XN, int gw_, int NGW_, int lane_) {
    asm volatile("" : "+v"(lane_));
    f32x4 gp[4], gn[4];
#pragma unroll
    for (int j = 0; j < 4; ++j) { gp[j] = ((const f32x4*)gpost)[lane_ + 64 * j]; gn[j] = gpre ? ((const f32x4*)gpre)[lane_ + 64 * j] : (f32x4){0.f, 0.f, 0.f, 0.f}; }
    for (int r = gw_; r < MT; r += NGW_) {
        const v2u* tr = (const v2u*)(T + (size_t)r * DM) + lane_;
        f32x4 t[4], x[4]; float s = 0.f;
#pragma unroll
        for (int j = 0; j < 4; ++j) { const v2u w = __builtin_nontemporal_load(tr + 64 * j); t[j] = (f32x4){bflo(w.x), bfhi(w.x), bflo(w.y), bfhi(w.y)}; s += (t[j].x * t[j].x + t[j].y * t[j].y) + (t[j].z * t[j].z + t[j].w * t[j].w); }
        if (XIN_BF) { const v2u* xr = (const v2u*)((const bf16*)xinA + (size_t)r * DM) + lane_;
#pragma unroll
            for (int j = 0; j < 4; ++j) { const v2u w = __builtin_nontemporal_load(xr + 64 * j); x[j] = (f32x4){bflo(w.x), bfhi(w.x), bflo(w.y), bfhi(w.y)}; } }
        else { const f32x4* xr = (const f32x4*)((r < MP) ? (const float*)xinA + (size_t)r * DM : (const float*)xinB + (size_t)(r - MP) * DM) + lane_;
#pragma unroll
            for (int j = 0; j < 4; ++j) x[j] = xr[64 * j]; }
        const float rs = 1.0f / sqrtf(wave_sum(s) * (1.f / DM) + EPS);
        float s2 = 0.f;
#pragma unroll
        for (int j = 0; j < 4; ++j) { x[j] = x[j] + t[j] * rs * gp[j]; s2 += (x[j].x * x[j].x + x[j].y * x[j].y) + (x[j].z * x[j].z + x[j].w * x[j].w); }
        if (XOUT_BF) { v2u* xo = (v2u*)((bf16*)xout + (size_t)r * DM) + lane_;
#pragma unroll
            for (int j = 0; j < 4; ++j) { v2u w; w.x = cvt_pk_bf16(x[j].x, x[j].y); w.y = cvt_pk_bf16(x[j].z, x[j].w); __builtin_nontemporal_store(w, xo + 64 * j); } }
        else { f32x4* xo = (f32x4*)((float*)xout + (size_t)r * DM) + lane_;
#pragma unroll
            for (int j = 0; j < 4; ++j) __builtin_nontemporal_store(x[j], xo + 64 * j); }
        if (XN) { const float rs2 = 1.0f / sqrtf(wave_sum(s2) * (1.f / DM) + EPS); v2u* o8 = (v2u*)(XN + (size_t)r * DM) + lane_;
#pragma unroll
            for (int j = 0; j < 4; ++j) { v2u w; w.x = cvt_pk_bf16(x[j].x * rs2 * gn[j].x, x[j].y * rs2 * gn[j].y); w.y = cvt_pk_bf16(x[j].z * rs2 * gn[j].z, x[j].w * rs2 * gn[j].w); o8[64 * j] = w; } }
    }
}

struct LayerIn { const float *sca, *scb, *sh, *caw, *cbw, *cbb, *wga, *bga, *wgx, *bgx, *lam; };
__device__ __forceinline__ float fsig(float x) { return __builtin_amdgcn_rcpf(1.0f + __expf(-x)); }
struct ConvA { const bf16* HB; const bf16* G; bf16* CA; float* pca; float* sa; };
__device__ __forceinline__ void bf8_to_f(const v4u w, float* g) { g[0] = bflo(w.x); g[1] = bfhi(w.x); g[2] = bflo(w.y); g[3] = bfhi(w.y); g[4] = bflo(w.z); g[5] = bfhi(w.z); g[6] = bflo(w.w); g[7] = bfhi(w.w); }
struct ConvAReg { v4u w0, wh, w1, w2; };
__device__ __forceinline__ void conva_load(const ConvA& C, int it, ConvAReg& R) {
        const int r = it >> 7, c = (it & 127) * 8;
        const int t = (r < MP) ? (r & (SEQ - 1)) : ((r - MP) & 7);
        R.w0 = *(const v4u*)(C.G + (size_t)r * DM + c); R.wh = __builtin_nontemporal_load((const v4u*)(C.HB + (size_t)r * DM + c));
        R.w1 = *(const v4u*)(C.G + (size_t)(r - (t >= 1 ? 1 : 0)) * DM + c); R.w2 = *(const v4u*)(C.G + (size_t)(r - (t >= 2 ? 2 : 0)) * DM + c);
}
__device__ __forceinline__ void conva_finish(const ConvA& C, const LayerIn& L, int it, const ConvAReg& R) {
        const int r = it >> 7, c = (it & 127) * 8;
        int t, b, TL; const bool smp = (r >= MP);
        if (!smp) { t = r & (SEQ - 1); b = r >> 11; TL = SEQ; } else { const int s = r - MP; t = s & 7; b = s >> 3; TL = DSEQ; }
        float g0[8], g1[8], g2[8], hb[8];
        bf8_to_f(R.w0, g0); bf8_to_f(R.wh, hb); bf8_to_f(R.w1, g1); bf8_to_f(R.w2, g2);
        if (t < 2) {
            if (smp) { const float* p2 = L.sca + ((size_t)b * 2 + t) * DM + c;
#pragma unroll
                for (int i = 0; i < 8; ++i) g2[i] = p2[i];
                if (t < 1) { const float* p1 = L.sca + ((size_t)b * 2 + 1) * DM + c;
#pragma unroll
                    for (int i = 0; i < 8; ++i) g1[i] = p1[i]; } }
            else {
#pragma unroll
                for (int i = 0; i < 8; ++i) { g2[i] = 0.f; if (t < 1) g1[i] = 0.f; } }
        }
        const f32x4 c0a = *(const f32x4*)(L.caw + c), c0b = *(const f32x4*)(L.caw + c + 4), c1a = *(const f32x4*)(L.caw + DM + c), c1b = *(const f32x4*)(L.caw + DM + c + 4), c2a = *(const f32x4*)(L.caw + 2 * DM + c), c2b = *(const f32x4*)(L.caw + 2 * DM + c + 4);
        float y[8];
#pragma unroll
        for (int i = 0; i < 8; ++i) { const float k0 = i < 4 ? c0a[i & 3] : c0b[i & 3], k1 = i < 4 ? c1a[i & 3] : c1b[i & 3], k2 = i < 4 ? c2a[i & 3] : c2b[i & 3]; y[i] = hb[i] * (k0 * g2[i] + k1 * g1[i] + k2 * g0[i]); }
        v4u o; o.x = cvt_pk_bf16(y[0], y[1]); o.y = cvt_pk_bf16(y[2], y[3]); o.z = cvt_pk_bf16(y[4], y[5]); o.w = cvt_pk_bf16(y[6], y[7]);
        *(v4u*)(C.CA + (size_t)r * DM + c) = o;
        if (t >= TL - 2) { float* dst = (smp ? C.sa : C.pca) + ((size_t)b * 2 + (t - (TL - 2))) * DM + c;
            *(f32x4*)dst = (f32x4){g0[0], g0[1], g0[2], g0[3]}; *(f32x4*)(dst + 4) = (f32x4){g0[4], g0[5], g0[6], g0[7]}; }
}
__device__ __forceinline__ void conva_item(const ConvA& C, const LayerIn& L, int it) { ConvAReg R; conva_load(C, it, R); conva_finish(C, L, it, R); }

constexpr int SC_UE = 0;
constexpr int SC_UCB = 45056;
constexpr int SC_UCF = 63488;
constexpr int SC_AA = 81920;
constexpr int SC_BB = 98304;
constexpr int SC_SEGA = 114688;
constexpr int SC_SEGB = 116736;
constexpr int SC_HIN = 118784;
constexpr int SC_HOUT = 120832;
constexpr int SC_WGT = 129024;
__device__ __forceinline__ void scan_unit(LAS unsigned char* lds, const bf16* U, bf16* HS, const LayerIn& L, float* pcb, float* ph, float* sb, float* sh, int kind, int sidx, int cgi, const ConvA& CV, int& cv_it, int cv_stride) {
    int tid_ = threadIdx.x; asm volatile("" : "+v"(tid_));
    const int tid = tid_, lane = tid & 63, w = tid >> 6, fr = lane & 15, fq = lane >> 4;
    const int nblk = cgi >> 1, cgh = cgi & 1, c0 = nblk * 64, cm0 = c0 + 32 * cgh;
    LAS float* UE = (LAS float*)(lds + SC_UE); LAS bf16* UCB = (LAS bf16*)(lds + SC_UCB); LAS float* UCF = (LAS float*)(lds + SC_UCF);
    LAS float* AA = (LAS float*)(lds + SC_AA); LAS float* BB = (LAS float*)(lds + SC_BB); LAS float* SEGA = (LAS float*)(lds + SC_SEGA);
    LAS float* SEGB = (LAS float*)(lds + SC_SEGB); LAS float* HIN = (LAS float*)(lds + SC_HIN); LAS bf16* HOUT = (LAS bf16*)(lds + SC_HOUT);
    LAS v4u* WGT = (LAS v4u*)(lds + SC_WGT);
#pragma unroll
    for (int nt = 0; nt < 2; ++nt)
#pragma unroll
        for (int ks = 0; ks < 2; ++ks) { const int j = 32 * cgh + 16 * nt + fr; const float* pa = L.wga + ((size_t)nblk * 64 + 32 * ks + 8 * fq) * 64 + j; const float* px = L.wgx + ((size_t)nblk * 64 + 32 * ks + 8 * fq) * 64 + j;
            unsigned a0 = cvt_pk_bf16(pa[0], pa[64]), a1 = cvt_pk_bf16(pa[128], pa[192]), a2 = cvt_pk_bf16(pa[256], pa[320]), a3 = cvt_pk_bf16(pa[384], pa[448]);
            unsigned x0 = cvt_pk_bf16(px[0], px[64]), x1 = cvt_pk_bf16(px[128], px[192]), x2 = cvt_pk_bf16(px[256], px[320]), x3 = cvt_pk_bf16(px[384], px[448]);
            v4u va = {a0, a1, a2, a3}, vx = {x0, x1, x2, x3};
            WGT[((nt * 2 + ks) * 2 + 0) * 64 + lane] = va; WGT[((nt * 2 + ks) * 2 + 1) * 64 + lane] = vx; }
    float ba[2], bx[2], sp8[2];
#pragma unroll
    for (int nt = 0; nt < 2; ++nt) { const int ch = cm0 + 16 * nt + fr; ba[nt] = L.bga[ch]; bx[nt] = L.bgx[ch]; sp8[nt] = 8.0f * log1pf(expf(-L.lam[ch])); }
    const int cgq = lane & 15;
    const f32x4 cw0 = *(const f32x4*)(L.cbw + c0 + 4 * cgq), cw1 = *(const f32x4*)(L.cbw + DM + c0 + 4 * cgq), cw2 = *(const f32x4*)(L.cbw + 2 * DM + c0 + 4 * cgq), cw3 = *(const f32x4*)(L.cbw + 3 * DM + c0 + 4 * cgq), cbias = *(const f32x4*)(L.cbb + c0 + 4 * cgq);
    float carry[2] = {0.f, 0.f};
    const int nch = (kind == 0) ? SEQ / 128 : 1;
    v4u pre0 = {0u, 0u, 0u, 0u}, pre1 = pre0, pre2 = pre0;
    int pt_[3], pc_[3], pl_[3];
#pragma unroll
    for (int i = 0; i < 3; ++i) { const int idx_ = tid + 512 * i, seg_ = idx_ / 88, rem_ = idx_ - seg_ * 88, j_ = rem_ >> 3, c8_ = rem_ & 7; pt_[i] = seg_ * 8 + j_ - 3; pc_[i] = c0 + 8 * c8_; pl_[i] = (seg_ * 11 + j_) * 64 + 8 * c8_; }
    const bool p2ok = tid < 1408 - 1024;
#define SC_PIECE(i, ckk, dstv) do { if ((i) < 2 || p2ok) { const int t_ = (ckk) * 128 + pt_[i]; \
        const v4u ld_ = *(const v4u*)(U + ((size_t)sidx * SEQ + (t_ < 0 ? 0 : t_)) * DM + pc_[i]); dstv = (t_ < 0) ? (v4u){0u, 0u, 0u, 0u} : ld_; } } while (0)
#define SC_PUT(i, srcv) do { if ((i) < 2 || p2ok) { LAS float* d_ = UE + pl_[i]; \
        *(LAS f32x4*)d_ = (f32x4){bflo(srcv.x), bfhi(srcv.x), bflo(srcv.y), bfhi(srcv.y)}; *(LAS f32x4*)(d_ + 4) = (f32x4){bflo(srcv.z), bfhi(srcv.z), bflo(srcv.w), bfhi(srcv.w)}; } } while (0)
    if (kind == 0) { SC_PIECE(0, 0, pre0); SC_PIECE(1, 0, pre1); SC_PIECE(2, 0, pre2); }
    for (int ck = 0; ck < nch; ++ck) {
        if (kind == 0) {
            SC_PUT(0, pre0); SC_PUT(1, pre1); SC_PUT(2, pre2);
            if (ck + 1 < nch) { SC_PIECE(0, ck + 1, pre0); SC_PIECE(1, ck + 1, pre1); SC_PIECE(2, ck + 1, pre2); }
        } else {
        for (int idx = tid; idx < 16 * 11 * 8; idx += 512) {
            const int seg = idx / 88, rem = idx - seg * 88, j = rem >> 3, c8 = rem & 7; float v[8];
            const int sq = sidx * 16 + seg;
            if (j < 3) { const float* p = L.scb + ((size_t)sq * 3 + j) * DM + c0 + 8 * c8; const f32x4 p0 = *(const f32x4*)p, p1 = *(const f32x4*)(p + 4);
                    v[0] = p0.x; v[1] = p0.y; v[2] = p0.z; v[3] = p0.w; v[4] = p1.x; v[5] = p1.y; v[6] = p1.z; v[7] = p1.w; }
            else { const v4u wv = *(const v4u*)(U + ((size_t)MP + sq * 8 + (j - 3)) * DM + c0 + 8 * c8); v[0] = bflo(wv.x); v[1] = bfhi(wv.x); v[2] = bflo(wv.y); v[3] = bfhi(wv.y); v[4] = bflo(wv.z); v[5] = bfhi(wv.z); v[6] = bflo(wv.w); v[7] = bfhi(wv.w); }
            LAS float* d = UE + (seg * 11 + j) * 64 + 8 * c8;
            *(LAS f32x4*)d = (f32x4){v[0], v[1], v[2], v[3]}; *(LAS f32x4*)(d + 4) = (f32x4){v[4], v[5], v[6], v[7]};
        }
        }
#if CONVA_INTERLEAVE
        ConvAReg cvr; const int cv_cur = cv_it; const bool cv_do = cv_cur < MT * 128;
        if (cv_do) { conva_load(CV, cv_cur, cvr); cv_it += cv_stride; }
#endif
        __syncthreads();
        for (int r1_ = 0; r1_ < REP_S1; ++r1_)
        { const int tk0 = 16 * w + 4 * fq, seg = tk0 >> 3, tt0 = tk0 & 7; const LAS float* p = UE + (seg * 11 + tt0) * 64 + 4 * cgq;
          f32x4 ur[7];
#pragma unroll
          for (int j = 0; j < 7; ++j) ur[j] = *(const LAS f32x4*)(p + 64 * j);
#pragma unroll
          for (int i = 0; i < 4; ++i) { const f32x4 uc = cbias + cw0 * ur[i] + cw1 * ur[i + 1] + cw2 * ur[i + 2] + cw3 * ur[i + 3];
              v2u pk; pk.x = cvt_pk_bf16(uc.x, uc.y); pk.y = cvt_pk_bf16(uc.z, uc.w); *(LAS v2u*)(UCB + (tk0 + i) * 72 + 4 * cgq) = pk;
              if ((cgq >> 3) == cgh) *(LAS f32x4*)(UCF + (tk0 + i) * 36 + 4 * (cgq & 7)) = uc; } }
        if (kind == 1 || ck == nch - 1)
        for (int idx = tid; idx < 16 * 3 * 32; idx += 512) { const int seg = idx / 96, jj = (idx >> 5) % 3, c = idx & 31; const float val = UE[(seg * 11 + 8 + jj) * 64 + 32 * cgh + c];
            if (kind == 1) sb[((size_t)(sidx * 16 + seg) * 3 + jj) * DM + cm0 + c] = val;
            else if (ck == nch - 1 && seg == 15) pcb[((size_t)sidx * 3 + jj) * DM + cm0 + c] = val; }
        LDS_WAIT(); asm volatile("" ::: "memory");
        f32x4 ra[2], rx[2];
        { bf16x8 af[2];
#pragma unroll
          for (int ks = 0; ks < 2; ++ks) af[ks] = *(const LAS bf16x8*)(UCB + (16 * w + fr) * 72 + 32 * ks + 8 * fq);
#pragma unroll
          for (int nt = 0; nt < 2; ++nt) { ra[nt] = (f32x4){0.f, 0.f, 0.f, 0.f}; rx[nt] = (f32x4){0.f, 0.f, 0.f, 0.f};
#pragma unroll
              for (int ks = 0; ks < 2; ++ks) { const bf16x8 wa_ = __builtin_bit_cast(bf16x8, WGT[((nt * 2 + ks) * 2 + 0) * 64 + lane]), wx_ = __builtin_bit_cast(bf16x8, WGT[((nt * 2 + ks) * 2 + 1) * 64 + lane]);
                  ra[nt] = __builtin_amdgcn_mfma_f32_16x16x32_bf16(af[ks], wa_, ra[nt], 0, 0, 0); rx[nt] = __builtin_amdgcn_mfma_f32_16x16x32_bf16(af[ks], wx_, rx[nt], 0, 0, 0); } } }
        float Ap[2][4], Bp[2][4], eA[2], eB[2], At[2], Bt[2];
#pragma unroll
        for (int nt = 0; nt < 2; ++nt) {
#pragma unroll
            for (int rg = 0; rg < 4; ++rg) { const int tk = 16 * w + 4 * fq + rg, c = 16 * nt + fr; const float uc = UCF[tk * 36 + c];
                const float r = fsig(ra[nt][rg] + ba[nt]), ii = fsig(rx[nt][rg] + bx[nt]); const float la = -sp8[nt] * r;
                const float av = __expf(la), bv = __builtin_amdgcn_sqrtf(fmaxf(1.0f - av * av, 0.f)) * ii * uc;
                if (rg == 0) { Ap[nt][0] = av; Bp[nt][0] = bv; } else { Ap[nt][rg] = av * Ap[nt][rg - 1]; Bp[nt][rg] = av * Bp[nt][rg - 1] + bv; } }
            float A_ = Ap[nt][3], B_ = Bp[nt][3];
            { const float pA = __shfl_up(A_, 16), pB = __shfl_up(B_, 16); const bool c1 = (kind == 0) ? (fq >= 1) : ((fq & 1) != 0); if (c1) { B_ = A_ * pB + B_; A_ = pA * A_; } }
            if (kind == 0) { const float pA = __shfl_up(A_, 32), pB = __shfl_up(B_, 32); if (fq >= 2) { B_ = A_ * pB + B_; A_ = pA * A_; } }
            { float xA = __shfl_up(A_, 16), xB = __shfl_up(B_, 16); const bool first = (kind == 0) ? (fq == 0) : ((fq & 1) == 0); if (first) { xA = 1.f; xB = 0.f; } eA[nt] = xA; eB[nt] = xB; }
            At[nt] = A_; Bt[nt] = B_;
        }
        float hst[2];
        if (kind == 0) {
            typedef float f32x2s __attribute__((ext_vector_type(2)));
            LAS f32x2s* SW = (LAS f32x2s*)(lds + SC_SEGA) + (ck & 1) * 256;
            if (fq == 3) { SW[w * 32 + fr] = (f32x2s){At[0], Bt[0]}; SW[w * 32 + 16 + fr] = (f32x2s){At[1], Bt[1]}; }
            __syncthreads();
#pragma unroll
            for (int nt = 0; nt < 2; ++nt) { float h = carry[nt], hin = 0.f;
#pragma unroll
                for (int ww = 0; ww < 8; ++ww) { const f32x2s ab = SW[ww * 32 + 16 * nt + fr]; if (ww == w) hin = h; h = ab.x * h + ab.y; }
                carry[nt] = h; hst[nt] = eA[nt] * hin + eB[nt]; }
        } else {
#pragma unroll
            for (int nt = 0; nt < 2; ++nt) { const float hin = L.sh[(size_t)(sidx * 16 + 2 * w + (fq >> 1)) * DM + cm0 + 16 * nt + fr]; hst[nt] = eA[nt] * hin + eB[nt]; }
        }
#pragma unroll
        for (int nt = 0; nt < 2; ++nt) {
#pragma unroll
            for (int rg = 0; rg < 4; ++rg) { const float h = Ap[nt][rg] * hst[nt] + Bp[nt][rg]; HOUT[(16 * w + 4 * fq + rg) * 32 + 16 * nt + fr] = (bf16)(cvt_pk_bf16(h, 0.f) & 0xffffu);
                if (rg == 3 && kind == 1 && (fq & 1)) sh[(size_t)(sidx * 16 + 2 * w + (fq >> 1)) * DM + cm0 + 16 * nt + fr] = h; }
            if (kind == 0 && ck == nch - 1 && w == 0 && fq == 0) ph[(size_t)sidx * DM + cm0 + 16 * nt + fr] = carry[nt];
        }
        LDS_WAIT(); asm volatile("" ::: "memory");
        for (int r3_ = 0; r3_ < REP_S3; ++r3_)
        { const int row = tid >> 2, part = tid & 3; const v4u v = *(const LAS v4u*)(HOUT + row * 32 + part * 8);
          const size_t grow = (kind == 0) ? (size_t)sidx * SEQ + ck * 128 + row : (size_t)MP + (size_t)sidx * 128 + row;
          *(v4u*)(HS + grow * DM + cm0 + part * 8) = v; }
#if CONVA_INTERLEAVE
        if (cv_do) conva_finish(CV, L, cv_cur, cvr);
#endif
    }
    __syncthreads();
#undef SC_PIECE
#undef SC_PUT
}

constexpr int KSTP = 272;
constexpr int KSTR = 264;
constexpr float SM_C = 0.0625f * 1.4426950408889634f;
__device__ __forceinline__ void attn_prompt_unit(LAS unsigned char* lds, const bf16* Q, const bf16* KB, const bf16* VT, bf16* O, int b, int h, int qt) {
    int tid_ = threadIdx.x; asm volatile("" : "+v"(tid_));
    const int tid = tid_, lane = tid & 63, w = tid >> 6, fr = lane & 15, fq = lane >> 4;
    LAS bf16* TL = (LAS bf16*)lds; LAS bf16* PW = (LAS bf16*)(lds + 64 * KSTP * 2 + w * (16 * KSTP * 2));
    const size_t qrow0 = (size_t)b * SEQ + qt * 128 + 16 * w;
    const int pm_ = tid >> 5, pc_ = (tid & 31) * 8;
    const bf16* ksrc = KB + ((size_t)b * NMEM + pm_) * DM + h * HD + pc_;
    const bf16* vsrc = VT + ((size_t)(b * NH + h) * HD + pm_) * NMEM + pc_;
    v4u nx0, nx1, nx2, nx3;
#define AT_LOADK(jt) do { const bf16* p_ = ksrc + (size_t)(64 * (jt)) * DM; nx0 = *(const v4u*)p_; nx1 = *(const v4u*)(p_ + 16 * DM); nx2 = *(const v4u*)(p_ + 32 * DM); nx3 = *(const v4u*)(p_ + 48 * DM); } while (0)
#define AT_LOADV(jt) do { const bf16* p_ = vsrc + (size_t)(64 * (jt)) * NMEM; nx0 = *(const v4u*)p_; nx1 = *(const v4u*)(p_ + 16 * NMEM); nx2 = *(const v4u*)(p_ + 32 * NMEM); nx3 = *(const v4u*)(p_ + 48 * NMEM); } while (0)
#define AT_PUT() do { LAS bf16* d_ = TL + pm_ * KSTP + pc_; *(LAS v4u*)d_ = nx0; *(LAS v4u*)(d_ + 16 * KSTP) = nx1; *(LAS v4u*)(d_ + 32 * KSTP) = nx2; *(LAS v4u*)(d_ + 48 * KSTP) = nx3; } while (0)
    AT_LOADK(0);
    bf16x8 qf[8];
#pragma unroll
    for (int ks = 0; ks < 8; ++ks) qf[ks] = *(const bf16x8*)(Q + (qrow0 + fr) * DM + h * HD + 32 * ks + 8 * fq);
    f32x4 s[16];
#pragma unroll
    for (int i = 0; i < 16; ++i) s[i] = (f32x4){0.f, 0.f, 0.f, 0.f};
#pragma unroll
    for (int jt = 0; jt < 4; ++jt) {
        AT_PUT();
        __syncthreads();
        if (jt < 3) AT_LOADK(jt + 1); else AT_LOADV(0);
        { bf16x8 fb[2][8];
#pragma unroll
          for (int ks = 0; ks < 8; ++ks) fb[0][ks] = *(const LAS bf16x8*)(TL + fr * KSTP + 32 * ks + 8 * fq);
#pragma unroll
          for (int nt = 0; nt < 4; ++nt) {
              if (nt < 3) {
#pragma unroll
                  for (int ks = 0; ks < 8; ++ks) fb[(nt + 1) & 1][ks] = *(const LAS bf16x8*)(TL + (16 * (nt + 1) + fr) * KSTP + 32 * ks + 8 * fq); }
              __builtin_amdgcn_sched_barrier(0); __builtin_amdgcn_s_setprio(1);
#pragma unroll
              for (int ks = 0; ks < 8; ++ks) s[4 * jt + nt] = __builtin_amdgcn_mfma_f32_16x16x32_bf16(fb[nt & 1][ks], qf[ks], s[4 * jt + nt], 0, 0, 0);
              __builtin_amdgcn_s_setprio(0); __builtin_amdgcn_sched_barrier(0);
          } }
        __syncthreads();
    }
    { float mx = s[0][0];
#pragma unroll
      for (int nt = 0; nt < 16; ++nt) mx = fmaxf(fmaxf(mx, fmaxf(s[nt][0], s[nt][1])), fmaxf(s[nt][2], s[nt][3]));
      mx = fmaxf(mx, __shfl_xor(mx, 16)); mx = fmaxf(mx, __shfl_xor(mx, 32));
      float sum = 0.f;
#pragma unroll
      for (int nt = 0; nt < 16; ++nt)
#pragma unroll
          for (int rg = 0; rg < 4; ++rg) { const float p = exp2f((s[nt][rg] - mx) * SM_C); s[nt][rg] = p; sum += p; }
      sum += __shfl_xor(sum, 16); sum += __shfl_xor(sum, 32);
      const float inv = 1.0f / sum;
#pragma unroll
      for (int nt = 0; nt < 16; ++nt) { v2u pk; pk.x = cvt_pk_bf16(s[nt][0] * inv, s[nt][1] * inv); pk.y = cvt_pk_bf16(s[nt][2] * inv, s[nt][3] * inv); *(LAS v2u*)(PW + fr * KSTP + 16 * nt + 4 * fq) = pk; } }
    LDS_WAIT(); asm volatile("" ::: "memory");
    bf16x8 pf[8];
#pragma unroll
    for (int ks = 0; ks < 8; ++ks) pf[ks] = *(const LAS bf16x8*)(PW + fr * KSTP + 32 * ks + 8 * fq);
#pragma unroll
    for (int jt = 0; jt < 4; ++jt) {
        AT_PUT();
        __syncthreads();
        if (jt < 3) AT_LOADV(jt + 1);
        { bf16x8 fb[2][8];
#pragma unroll
          for (int ks = 0; ks < 8; ++ks) fb[0][ks] = *(const LAS bf16x8*)(TL + fr * KSTP + 32 * ks + 8 * fq);
#pragma unroll
          for (int nt = 0; nt < 4; ++nt) { f32x4 o = (f32x4){0.f, 0.f, 0.f, 0.f};
              if (nt < 3) {
#pragma unroll
                  for (int ks = 0; ks < 8; ++ks) fb[(nt + 1) & 1][ks] = *(const LAS bf16x8*)(TL + (16 * (nt + 1) + fr) * KSTP + 32 * ks + 8 * fq); }
              __builtin_amdgcn_sched_barrier(0); __builtin_amdgcn_s_setprio(1);
#pragma unroll
              for (int ks = 0; ks < 8; ++ks) o = __builtin_amdgcn_mfma_f32_16x16x32_bf16(fb[nt & 1][ks], pf[ks], o, 0, 0, 0);
              __builtin_amdgcn_s_setprio(0); __builtin_amdgcn_sched_barrier(0);
              v2u pk; pk.x = cvt_pk_bf16(o[0], o[1]); pk.y = cvt_pk_bf16(o[2], o[3]);
              *(v2u*)(O + (qrow0 + fr) * DM + h * HD + 64 * jt + 16 * nt + 4 * fq) = pk; } }
        __syncthreads();
    }
#undef AT_LOADK
#undef AT_LOADV
#undef AT_PUT
}
__device__ __forceinline__ void attn_sample_units(LAS unsigned char* lds, const bf16* Q, const float* CK, const float* CV, bf16* O, int first, int stride) {
    int tid_ = threadIdx.x; asm volatile("" : "+v"(tid_));
    const int tid = tid_, lane = tid & 63, w = tid >> 6, fr = lane & 15, fq = lane >> 4;
    LAS bf16* KS = (LAS bf16*)lds; LAS bf16* PS = (LAS bf16*)(lds + 135168); LAS float* RED = (LAS float*)(lds + 143616);
    constexpr int KPF = 8;
    f32x4 kp[KPF];
#define AS_KBASE(u_) (CK + ((size_t)((u_) >> 2) * NMEM * NH + ((u_) & 3)) * HD)
#define AS_KLOAD(u_) do { const float* kb_ = AS_KBASE(u_); _Pragma("unroll") for (int i = 0; i < KPF; ++i) { const int idx = i * 512 + tid, m = idx >> 6, d4 = idx & 63; kp[i] = __builtin_nontemporal_load((const f32x4*)(kb_ + (size_t)m * DM + 4 * d4)); } } while (0)
    int u = first;
    if (u < 512) AS_KLOAD(u);
    for (; u < 512; u += stride) {
        const int b = u >> 2, h = u & 3;
        const float* kbase = AS_KBASE(u);
        const float* vbase = CV + ((size_t)b * NMEM * NH + h) * HD;
#pragma unroll
        for (int i = 0; i < KPF; ++i) { const int idx = i * 512 + tid, m = idx >> 6, d4 = idx & 63; v2u o; o.x = cvt_pk_bf16(kp[i].x, kp[i].y); o.y = cvt_pk_bf16(kp[i].z, kp[i].w); *(LAS v2u*)(KS + m * KSTR + 4 * d4) = o; }
#pragma unroll 8
        for (int i = KPF; i < 32; ++i) { const int idx = i * 512 + tid, m = idx >> 6, d4 = idx & 63; const f32x4 v = __builtin_nontemporal_load((const f32x4*)(kbase + (size_t)m * DM + 4 * d4));
            v2u o; o.x = cvt_pk_bf16(v.x, v.y); o.y = cvt_pk_bf16(v.z, v.w); *(LAS v2u*)(KS + m * KSTR + 4 * d4) = o; }
        bf16x8 qf[8];
#pragma unroll
        for (int ks = 0; ks < 8; ++ks) { if (fr < 8) qf[ks] = *(const bf16x8*)(Q + ((size_t)MP + b * DSEQ + fr) * DM + h * HD + 32 * ks + 8 * fq); else qf[ks] = (bf16x8){0, 0, 0, 0, 0, 0, 0, 0}; }
        __syncthreads();
        f32x4 vp[16];
#pragma unroll
        for (int i = 0; i < 8; ++i) { const int mp = i * 8 + (lane & 7), d4 = w * 8 + (lane >> 3);
            vp[2 * i] = __builtin_nontemporal_load((const f32x4*)(vbase + (size_t)(2 * mp) * DM + 4 * d4)); vp[2 * i + 1] = __builtin_nontemporal_load((const f32x4*)(vbase + (size_t)(2 * mp + 1) * DM + 4 * d4)); }
        f32x4 s[2];
#pragma unroll
        for (int nt = 0; nt < 2; ++nt) { s[nt] = (f32x4){0.f, 0.f, 0.f, 0.f};
#pragma unroll
            for (int ks = 0; ks < 8; ++ks) { const bf16x8 bfr = *(const LAS bf16x8*)(KS + (32 * w + 16 * nt + fr) * KSTR + 32 * ks + 8 * fq); s[nt] = __builtin_amdgcn_mfma_f32_16x16x32_bf16(bfr, qf[ks], s[nt], 0, 0, 0); } }
        { float m_ = fmaxf(fmaxf(fmaxf(s[0][0], s[0][1]), fmaxf(s[0][2], s[0][3])), fmaxf(fmaxf(s[1][0], s[1][1]), fmaxf(s[1][2], s[1][3])));
          m_ = fmaxf(m_, __shfl_xor(m_, 16)); m_ = fmaxf(m_, __shfl_xor(m_, 32));
          if (fq == 0) RED[w * 16 + fr] = m_; }
        __syncthreads();
        { float m_ = RED[fr];
#pragma unroll
          for (int ww = 1; ww < 8; ++ww) m_ = fmaxf(m_, RED[ww * 16 + fr]);
          float sum = 0.f;
#pragma unroll
          for (int nt = 0; nt < 2; ++nt)
#pragma unroll
              for (int rg = 0; rg < 4; ++rg) { const float p = exp2f((s[nt][rg] - m_) * SM_C); s[nt][rg] = p; sum += p; }
          sum += __shfl_xor(sum, 16); sum += __shfl_xor(sum, 32);
          if (fq == 0) RED[128 + w * 16 + fr] = sum; }
#pragma unroll
        for (int i = 0; i < 8; ++i) { const int mp = i * 8 + (lane & 7), d4 = w * 8 + (lane >> 3); const f32x4 v0 = vp[2 * i], v1 = vp[2 * i + 1];
            LAS unsigned* dst = (LAS unsigned*)(KS + (4 * d4) * KSTR + 2 * mp);
            dst[0] = cvt_pk_bf16(v0.x, v1.x); dst[KSTR / 2] = cvt_pk_bf16(v0.y, v1.y); dst[KSTR] = cvt_pk_bf16(v0.z, v1.z); dst[3 * KSTR / 2] = cvt_pk_bf16(v0.w, v1.w); }
#pragma unroll 4
        for (int i = 8; i < 16; ++i) { const int mp = i * 8 + (lane & 7), d4 = w * 8 + (lane >> 3);
            const f32x4 v0 = __builtin_nontemporal_load((const f32x4*)(vbase + (size_t)(2 * mp) * DM + 4 * d4)), v1 = __builtin_nontemporal_load((const f32x4*)(vbase + (size_t)(2 * mp + 1) * DM + 4 * d4));
            LAS unsigned* dst = (LAS unsigned*)(KS + (4 * d4) * KSTR + 2 * mp);
            dst[0] = cvt_pk_bf16(v0.x, v1.x); dst[KSTR / 2] = cvt_pk_bf16(v0.y, v1.y); dst[KSTR] = cvt_pk_bf16(v0.z, v1.z); dst[3 * KSTR / 2] = cvt_pk_bf16(v0.w, v1.w); }
        __syncthreads();
        { float tot = RED[128 + fr];
#pragma unroll
          for (int ww = 1; ww < 8; ++ww) tot += RED[128 + ww * 16 + fr];
          const float inv = 1.0f / tot;
#pragma unroll
          for (int nt = 0; nt < 2; ++nt) { v2u pk; pk.x = cvt_pk_bf16(s[nt][0] * inv, s[nt][1] * inv); pk.y = cvt_pk_bf16(s[nt][2] * inv, s[nt][3] * inv); *(LAS v2u*)(PS + fr * KSTR + 32 * w + 16 * nt + 4 * fq) = pk; } }
        __syncthreads();
        if (u + stride < 512) AS_KLOAD(u + stride);
#pragma unroll
        for (int nt = 0; nt < 2; ++nt) { f32x4 o = (f32x4){0.f, 0.f, 0.f, 0.f};
#pragma unroll
            for (int ks = 0; ks < 8; ++ks) { const bf16x8 pfr = *(const LAS bf16x8*)(PS + fr * KSTR + 32 * ks + 8 * fq); const bf16x8 bfr = *(const LAS bf16x8*)(KS + (32 * w + 16 * nt + fr) * KSTR + 32 * ks + 8 * fq);
                o = __builtin_amdgcn_mfma_f32_16x16x32_bf16(bfr, pfr, o, 0, 0, 0); }
            if (fr < 8) { v2u pk; pk.x = cvt_pk_bf16(o[0], o[1]); pk.y = cvt_pk_bf16(o[2], o[3]); *(v2u*)(O + ((size_t)MP + b * DSEQ + fr) * DM + h * HD + 32 * w + 16 * nt + 4 * fq) = pk; } }
        __syncthreads();
    }
#undef AS_KBASE
#undef AS_KLOAD
}
template <int KS, class Epi> __device__ __forceinline__ void mini_gemm(LAS unsigned char* lds, const bf16* A, const bf16* Bt, int K, int N, int row_base, int nrows, const Epi& E, int first, int stride) {
    int tid_ = threadIdx.x; asm volatile("" : "+v"(tid_));
    const int lane = tid_ & 63, w = tid_ >> 6, fr = lane & 15, fq = lane >> 4;
    const int ntn = N / 64, ntiles = (nrows / 64) * ntn;
    LAS f32x4* RED = (LAS f32x4*)lds;
    for (int t = first; t < ntiles; t += stride) {
        const int tm = t / ntn, tn = t - tm * ntn;
        const int r0 = row_base + tm * 64, c0 = tn * 64;
        const bf16* ap = A + (size_t)(r0 + fr) * K + 8 * fq + 32 * w * KS;
        const bf16* bp = Bt + (size_t)(c0 + fr) * K + 8 * fq + 32 * w * KS;
        f32x4 acc[4][4];
#pragma unroll
        for (int i = 0; i < 4; ++i)
#pragma unroll
            for (int j = 0; j < 4; ++j) acc[i][j] = (f32x4){0.f, 0.f, 0.f, 0.f};
#pragma unroll
        for (int k0 = 0; k0 < KS; k0 += 4) { bf16x8 a[4][4], b[4][4];
#pragma unroll
            for (int kk = 0; kk < 4; ++kk) if (k0 + kk < KS) {
#pragma unroll
                for (int i = 0; i < 4; ++i) { a[kk][i] = *(const bf16x8*)(ap + (size_t)(16 * i) * K + 32 * (k0 + kk)); b[kk][i] = *(const bf16x8*)(bp + (size_t)(16 * i) * K + 32 * (k0 + kk)); } }
            __builtin_amdgcn_sched_barrier(0);
#pragma unroll
            for (int kk = 0; kk < 4; ++kk) if (k0 + kk < KS) {
#pragma unroll
                for (int i = 0; i < 4; ++i)
#pragma unroll
                    for (int j = 0; j < 4; ++j) acc[i][j] = __builtin_amdgcn_mfma_f32_16x16x32_bf16(b[kk][j], a[kk][i], acc[i][j], 0, 0, 0); }
            __builtin_amdgcn_sched_barrier(0);
        }
#pragma unroll
        for (int i = 0; i < 4; ++i)
#pragma unroll
            for (int j = 0; j < 4; ++j) RED[(w * 16 + i * 4 + j) * 64 + lane] = acc[i][j];
        __syncthreads();
#pragma unroll
        for (int q = 0; q < 2; ++q) { const int st = 2 * w + q, mt = st >> 2, nt = st & 3; f32x4 v = RED[st * 64 + lane];
#pragma unroll
            for (int ww = 1; ww < 8; ++ww) v = v + RED[(ww * 16 + st) * 64 + lane];
            E.apply(r0 + 16 * mt + fr, c0 + 16 * nt + 4 * fq, v); }
        __syncthreads();
    }
}

__device__ __forceinline__ void mini_gemm_dual(LAS unsigned char* lds, const bf16* A1, const bf16* B1, const bf16* A2, const bf16* B2, const bf16* m1, const bf16* m2, bf16* Zo, int row_base, int nrows, int first, int stride) {
    int tid_ = threadIdx.x; asm volatile("" : "+v"(tid_));
    const int lane = tid_ & 63, w = tid_ >> 6, fr = lane & 15, fq = lane >> 4;
    constexpr int K = DM, KS = 4; const int ntn = DM / 64, ntiles = (nrows / 64) * ntn;
    LAS f32x4* RED = (LAS f32x4*)lds;
    for (int t = first; t < ntiles; t += stride) {
        const int tm = t / ntn, tn = t - tm * ntn;
        const int r0 = row_base + tm * 64, c0 = tn * 64;
        f32x4 zkeep[2];
#pragma unroll
        for (int pass = 0; pass < 2; ++pass) {
            const bf16* ap = (pass ? A2 : A1) + (size_t)(r0 + fr) * K + 8 * fq + 32 * w * KS;
            const bf16* bp = (pass ? B2 : B1) + (size_t)(c0 + fr) * K + 8 * fq + 32 * w * KS;
            f32x4 acc[4][4];
#pragma unroll
            for (int i = 0; i < 4; ++i)
#pragma unroll
                for (int j = 0; j < 4; ++j) acc[i][j] = (f32x4){0.f, 0.f, 0.f, 0.f};
            bf16x8 a[4][4], b[4][4];
#pragma unroll
            for (int kk = 0; kk < 4; ++kk)
#pragma unroll
                for (int i = 0; i < 4; ++i) { a[kk][i] = *(const bf16x8*)(ap + (size_t)(16 * i) * K + 32 * kk); b[kk][i] = *(const bf16x8*)(bp + (size_t)(16 * i) * K + 32 * kk); }
            __builtin_amdgcn_sched_barrier(0);
#pragma unroll
            for (int kk = 0; kk < 4; ++kk)
#pragma unroll
                for (int i = 0; i < 4; ++i)
#pragma unroll
                    for (int j = 0; j < 4; ++j) acc[i][j] = __builtin_amdgcn_mfma_f32_16x16x32_bf16(b[kk][j], a[kk][i], acc[i][j], 0, 0, 0);
            __builtin_amdgcn_sched_barrier(0);
#pragma unroll
            for (int i = 0; i < 4; ++i)
#pragma unroll
                for (int j = 0; j < 4; ++j) RED[(w * 16 + i * 4 + j) * 64 + lane] = acc[i][j];
            __syncthreads();
#pragma unroll
            for (int q = 0; q < 2; ++q) { const int st = 2 * w + q, mt = st >> 2, nt = st & 3; f32x4 v = RED[st * 64 + lane];
#pragma unroll
                for (int ww = 1; ww < 8; ++ww) v = v + RED[(ww * 16 + st) * 64 + lane];
                const size_t o = (size_t)(r0 + 16 * mt + fr) * DM + c0 + 16 * nt + 4 * fq;
                if (pass == 0) { zkeep[q] = v * pg8::ld_bf16x4(m1 + o); }
                else { pg8::st_bf16x4(Zo + o, zkeep[q] + v * pg8::ld_bf16x4(m2 + o)); } }
            __syncthreads();
        }
    }
}

struct Args { const float* in[26]; float* out; unsigned char* ws; };
typedef __attribute__((address_space(4))) const unsigned char* karg_t;
__device__ __forceinline__ const float* karg_in(int i) { karg_t p = (karg_t)__builtin_amdgcn_kernarg_segment_ptr(); asm volatile("" : "+s"(p)); return *(const float* __attribute__((address_space(4))) const*)(p + 8 * i); }
__device__ __forceinline__ float* karg_out() { karg_t p = (karg_t)__builtin_amdgcn_kernarg_segment_ptr(); asm volatile("" : "+s"(p)); return *(float* __attribute__((address_space(4))) const*)(p + 8 * 26); }
__device__ __forceinline__ unsigned char* karg_ws() { karg_t p = (karg_t)__builtin_amdgcn_kernarg_segment_ptr(); asm volatile("" : "+s"(p)); return *(unsigned char* __attribute__((address_space(4))) const*)(p + 8 * 27); }
#define ARGIN(i) karg_in(i)
__device__ __forceinline__ int opaque_i(int v) { asm volatile("" : "+s"(v)); return v; }
__device__ __forceinline__ int vcu_of(int g, int b) { return (g % 8 == 0) ? (b % 8) * (g / 8) + b / 8 : b; }
__global__ void __launch_bounds__(NWAVES * 64, 2) fwd_megakernel(Args args_unused) {
    extern __shared__ __attribute__((aligned(16))) unsigned char lds_raw[];
    LAS unsigned char* lds = (LAS unsigned char*)lds_raw;
#define tid ((int)threadIdx.x)
#define lane (tid & 63)
#define wave (__builtin_amdgcn_readfirstlane(tid >> 6))
#define G (opaque_i((int)gridDim.x))
#define bx ((int)blockIdx.x)
#define vcu (vcu_of(G, bx))
    for (int u = tid; u < 256; u += NWAVES * 64) ((LAS unsigned*)(lds + MISC_OFF))[u] = 0u;
    __syncthreads();
    XcdBarrier bar = xcd_barrier_post((unsigned*)(karg_ws() + WS_CTL) + CW_BAR, (volatile LAS unsigned*)(lds + MISC_OFF) + 8);
#define GRID_BAR() do { for (int rb_ = 0; rb_ < REP_BAR; ++rb_) xcd_barrier(bar); } while (0)
#define gw (vcu * NWAVES + wave)
#define NGW (G * NWAVES)
#define ws (karg_ws())
#define out (karg_out())
#define XN ((bf16*)(ws + WS_XN))
#define MN ((bf16*)(ws + WS_MN))
#define PROJ ((bf16*)(ws + WS_PROJ))
#define CA ((bf16*)(ws + WS_CA))
#define HS ((bf16*)(ws + WS_HS))
#define YC ((bf16*)(ws + WS_YC))
#define Z ((bf16*)(ws + WS_Z))
#define T ((bf16*)(ws + WS_T))
#define X ((bf16*)(ws + WS_X))
#define Qb ((bf16*)(ws + WS_Q))
#define Ob ((bf16*)(ws + WS_O))
#define ACT ((bf16*)(ws + WS_ACT))
#define MKB ((bf16*)(ws + WS_MKB))
#define MVT ((bf16*)(ws + WS_MVT))
#define gains (ARGIN(8))
#if (PHM >> 0) & 1
    for (int rp_ = 0; rp_ < REP_PRO; ++rp_) {
        LAS float* scr = (LAS float*)(lds + wave * 16384);
        constexpr int NIT = 10880;
        for (int it = gw; it < 2 * NIT; it += NGW) {
            const int l = it / NIT; int r = it - l * NIT; bf16* wb = (bf16*)(ws + WS_W + (size_t)l * W_LAYER);
            if (r < 3072) { transpose_item(ARGIN(9) + (size_t)l * DM * DIN, DM, DIN, (bf16*)((unsigned char*)wb + WO_IN), 1, scr, r, lane); continue; } r -= 3072;
            if (r < 512) { transpose_item(ARGIN(11) + (size_t)l * DM * DM, DM, DM, (bf16*)((unsigned char*)wb + WO_CO), 0, scr, r, lane); continue; } r -= 512;
            if (r < 512) { transpose_item(ARGIN(19) + (size_t)l * DM * DM, DM, DM, (bf16*)((unsigned char*)wb + WO_RO), 0, scr, r, lane); continue; } r -= 512;
            if (r < 512) { transpose_item(ARGIN(20) + (size_t)l * DM * DM, DM, DM, (bf16*)((unsigned char*)wb + WO_MIX), 0, scr, r, lane); continue; } r -= 512;
            if (r < 1024) { transpose_item(ARGIN(21) + (size_t)l * DM * 2 * DM, DM, 2 * DM, (bf16*)((unsigned char*)wb + WO_KV), 0, scr, r, lane); continue; } r -= 1024;
            if (r < 512) { transpose_item(ARGIN(22) + (size_t)l * DM * DM, DM, DM, (bf16*)((unsigned char*)wb + WO_Q), 0, scr, r, lane); continue; } r -= 512;
            if (r < 512) { transpose_item(ARGIN(23) + (size_t)l * DM * DM, DM, DM, (bf16*)((unsigned char*)wb + WO_O), 0, scr, r, lane); continue; } r -= 512;
            if (r < 2816) { transpose_item(ARGIN(24) + (size_t)l * DM * 2 * DFF, DM, 2 * DFF, (bf16*)((unsigned char*)wb + WO_FI), 2, scr, r, lane); continue; } r -= 2816;
            transpose_item(ARGIN(25) + (size_t)l * DFF * DM, DFF, DM, (bf16*)((unsigned char*)wb + WO_FO), 0, scr, r, lane);
        }
        for (int m = gw; m < MT; m += NGW) rms_row_to_bf16((m < MP) ? ARGIN(0) + (size_t)m * DM : ARGIN(1) + (size_t)(m - MP) * DM, gains, XN + (size_t)m * DM, lane);
        for (int m = gw; m < 2 * MROWS; m += NGW) { const int l = m / MROWS, rr = m - l * MROWS; rms_row_to_bf16(ARGIN(7) + (size_t)rr * DM, gains + ((size_t)l * 7 + 6) * DM, MN + (size_t)m * DM, lane); }
    }
    GRID_BAR();

#endif
#if (PHM >> 1) & 1
    for (int l = 0; l < DEPTH; ++l) {
        const bf16* wkv = (const bf16*)(ws + WS_W + (size_t)l * W_LAYER + WO_KV);
        pg8::Gemm g{MN + (size_t)l * MROWS * DM, wkv, MROWS, 2 * DM, DM}; pg8::StaticOrder S; const int cmk = bx - 96 - 64 * l;
        S.init(MROWS, 2 * DM, G, (G == 256) ? ((cmk >= 0 && cmk < 64) ? cmk : (1 << 20)) : bx);
        pg8::EpiMemKV E{out + OFF_PK + (size_t)l * MROWS * DM, out + OFF_PV + (size_t)l * MROWS * DM, MKB + (size_t)l * MROWS * DM, MVT + (size_t)l * MROWS * DM};
        pg8::gemm_phase<pg8::EpiMemKV, pg8::StaticOrder, true, true>(lds, g, S, E);
    }
#endif

    for (int l = 0; l < DEPTH; ++l) {
#define wl ((const unsigned char*)(ws + WS_W + (size_t)l * W_LAYER))
#define gl (gains + (size_t)l * 7 * DM)
#define MAKE_L() LayerIn L; L.sca = ARGIN(2) + (size_t)l * DB * 2 * DM; L.scb = ARGIN(3) + (size_t)l * DB * 3 * DM; L.sh = ARGIN(4) + (size_t)l * DB * DM; \
        L.caw = ARGIN(10) + (size_t)l * 3 * DM; L.cbw = ARGIN(12) + (size_t)l * 4 * DM; L.cbb = ARGIN(13) + (size_t)l * DM; \
        L.wga = ARGIN(14) + (size_t)l * 16 * 64 * 64; L.bga = ARGIN(15) + (size_t)l * DM; L.wgx = ARGIN(16) + (size_t)l * 16 * 64 * 64; L.bgx = ARGIN(17) + (size_t)l * DM; L.lam = ARGIN(18) + (size_t)l * DM
#if (PHM >> 2) & 1
        { pg8::Gemm g{XN, (const bf16*)(wl + WO_IN), MT, DIN, DM}; pg8::StaticOrder S; S.init(MT, DIN, G, bx); pg8::EpiInProj E{PROJ, SLOT};
          pg8::gemm_phase<pg8::EpiInProj, pg8::StaticOrder, true, true>(lds, g, S, E); }
        GRID_BAR();
#endif
#if (PHM >> 3) & 1
        for (int rs_ = 0; rs_ < REP_SCAN; ++rs_) { MAKE_L();
          ConvA CV{PROJ, PROJ + SLOT, CA, out + OFF_PCA + (size_t)l * 8 * 2 * DM, out + OFF_SA + (size_t)l * DB * 2 * DM};
          int cv_it = vcu * 512 + tid; asm volatile("" : "+v"(cv_it)); const int cv_stride = G * 512;
          for (int u = vcu; u < 512; u += G) { const int kind = u >> 8, uu = u & 255;
              scan_unit(lds, PROJ + 2 * SLOT, HS, L, out + OFF_PCB + (size_t)l * 8 * 3 * DM, out + OFF_PH + (size_t)l * 8 * DM, out + OFF_SB + (size_t)l * DB * 3 * DM, out + OFF_SH + (size_t)l * DB * DM, kind, uu >> 5, uu & 31, CV, cv_it, cv_stride); }
          for (; cv_it < MT * 128; cv_it += cv_stride) conva_item(CV, L, cv_it); }
        GRID_BAR();
#endif
#if (PHM >> 4) & 1
        { pg8::Gemm g{CA, (const bf16*)(wl + WO_CO), MP, DM, DM}; pg8::StaticOrder S; S.init(MP, DM, G, bx); pg8::EpiBf<1> E{YC, PROJ + 3 * SLOT, nullptr, DM};
          pg8::gemm_phase<pg8::EpiBf<1>, pg8::StaticOrder, true, true>(lds, g, S, E);
          }
        asm volatile("s_waitcnt vmcnt(0)" ::: "memory"); __syncthreads();
#endif
#if (PHM >> 5) & 1
        { pg8::Gemm g{HS, (const bf16*)(wl + WO_RO), MP, DM, DM}; pg8::StaticOrder S; S.init(MP, DM, G, bx); pg8::EpiBf<2> E{Z, PROJ + 4 * SLOT, YC, DM};
          pg8::gemm_phase<pg8::EpiBf<2>, pg8::StaticOrder, true, true>(lds, g, S, E);
          mini_gemm_dual(lds, CA, (const bf16*)(wl + WO_CO), HS, (const bf16*)(wl + WO_RO), PROJ + 3 * SLOT, PROJ + 4 * SLOT, Z, MP, MS, vcu, G); }
        GRID_BAR();
#endif
#if (PHM >> 6) & 1
        { pg8::Gemm g{Z, (const bf16*)(wl + WO_MIX), MP, DM, DM}; pg8::StaticOrder S; S.init(MP, DM, G, bx); pg8::EpiBf<0> E{T, nullptr, nullptr, DM};
          pg8::gemm_phase<pg8::EpiBf<0>, pg8::StaticOrder, true, true>(lds, g, S, E);
          for (int rm_ = 0; rm_ < REP_MINI; ++rm_) mini_gemm<4>(lds, Z, (const bf16*)(wl + WO_MIX), DM, DM, MP, MS, E, vcu, G); }
        GRID_BAR();
#endif
#if (PHM >> 7) & 1
        if (l == 0) row_phase<false, true>(T, ARGIN(0), ARGIN(1), X, gl + 1 * DM, gl + 2 * DM, XN, gw, NGW, lane);
        else row_phase<true, true>(T, X, nullptr, X, gl + 1 * DM, gl + 2 * DM, XN, gw, NGW, lane);
        GRID_BAR();
#endif
#if (PHM >> 8) & 1
        { pg8::Gemm g{XN, (const bf16*)(wl + WO_Q), MP, DM, DM}; pg8::StaticOrder S; S.init(MP, DM, G, bx); pg8::EpiBf<0> E{Qb, nullptr, nullptr, DM};
          pg8::gemm_phase<pg8::EpiBf<0>, pg8::StaticOrder, true, true>(lds, g, S, E);
          for (int rm_ = 0; rm_ < REP_MINI; ++rm_) mini_gemm<4>(lds, XN, (const bf16*)(wl + WO_Q), DM, DM, MP, MS, E, vcu, G); }
        GRID_BAR();
#endif
#if (PHM >> 9) & 1
        for (int ra_ = 0; ra_ < REP_ATTN; ++ra_) {
          const bool sample_first = (vcu & 1) != 0;
          for (int ph = 0; ph < 2; ++ph) {
            if ((ph == 0) != sample_first) { for (int u = vcu; u < 512; u += G) attn_prompt_unit(lds, Qb, MKB + (size_t)l * MROWS * DM, MVT + (size_t)l * MROWS * DM, Ob, u >> 6, (u >> 4) & 3, u & 15); }
            else { const float* ck = ARGIN(5) + (size_t)l * DB * NMEM * DM; const float* cv = ARGIN(6) + (size_t)l * DB * NMEM * DM;
              for (int rs2_ = 0; rs2_ < REP_ATTS; ++rs2_) attn_sample_units(lds, Qb, ck, cv, Ob, vcu, G); }
          } }
        GRID_BAR();
#endif
#if (PHM >> 10) & 1
        { pg8::Gemm g{Ob, (const bf16*)(wl + WO_O), MP, DM, DM}; pg8::StaticOrder S; S.init(MP, DM, G, bx); pg8::EpiBf<0> E{T, nullptr, nullptr, DM};
          pg8::gemm_phase<pg8::EpiBf<0>, pg8::StaticOrder, true, true>(lds, g, S, E);
          for (int rm_ = 0; rm_ < REP_MINI; ++rm_) mini_gemm<4>(lds, Ob, (const bf16*)(wl + WO_O), DM, DM, MP, MS, E, vcu, G); }
        GRID_BAR();
#endif
#if (PHM >> 11) & 1
        row_phase<true, true>(T, X, nullptr, X, gl + 3 * DM, gl + 4 * DM, XN, gw, NGW, lane);
        GRID_BAR();
#endif
#if (PHM >> 12) & 1
        { pg8::Gemm g{XN, (const bf16*)(wl + WO_FI), MT, 2 * DFF, DM}; pg8::StaticOrder S; S.init(MT, 2 * DFF, G, bx); pg8::EpiSwiGLU E{ACT, DFF};
          pg8::gemm_phase<pg8::EpiSwiGLU, pg8::StaticOrder, true, true>(lds, g, S, E); }
        GRID_BAR();
#endif
#if (PHM >> 13) & 1
        { pg8::Gemm g{ACT, (const bf16*)(wl + WO_FO), MP, DM, DFF}; pg8::StaticOrder S; S.init(MP, DM, G, bx); pg8::EpiBf<0> E{T, nullptr, nullptr, DM};
          pg8::gemm_phase<pg8::EpiBf<0>, pg8::StaticOrder, true, true>(lds, g, S, E);
          for (int rm_ = 0; rm_ < REP_MINI; ++rm_) mini_gemm<11>(lds, ACT, (const bf16*)(wl + WO_FO), DFF, DM, MP, MS, E, vcu, G); }
        GRID_BAR();
#endif
#if (PHM >> 14) & 1
        if (l == DEPTH - 1) row_phase<true, false>(T, X, nullptr, out + OFF_Y, gl + 5 * DM, nullptr, nullptr, gw, NGW, lane);
        else row_phase<true, true>(T, X, nullptr, X, gl + 5 * DM, gains + (size_t)(l + 1) * 7 * DM, XN, gw, NGW, lane);
#endif
        if (l != DEPTH - 1) GRID_BAR();
    }
    if (G == 0x7ffffff0) cg::this_grid().sync();
}

#undef tid
#undef lane
#undef wave
#undef G
#undef bx
#undef vcu
#undef gw
#undef NGW
#undef ws
#undef out
#undef XN
#undef MN
#undef PROJ
#undef CA
#undef HS
#undef YC
#undef Z
#undef T
#undef X
#undef Qb
#undef Ob
#undef ACT
#undef MKB
#undef MVT
#undef gains
#undef wl
#undef gl
extern "C" void kernel_launch(void* const* d_in, const int* in_sizes, int n_in, void* d_out, int out_size, void* d_ws, size_t ws_size, hipStream_t stream) {
    static int grid = 0;
    if (grid == 0) {
        if (n_in != 26 || (size_t)out_size != OUT_TOTAL || ws_size < WS_END) { fprintf(stderr, "kernel_launch: unexpected shapes: n_in %d out %d ws %zu\n", n_in, out_size, ws_size); grid = -1; return; }
        int dev = 0, cus = 0, per_cu = 0;
        if (hipGetDevice(&dev) != hipSuccess || hipDeviceGetAttribute(&cus, hipDeviceAttributeMultiprocessorCount, dev) != hipSuccess) { grid = -1; return; }
        if (hipFuncSetAttribute((const void*)fwd_megakernel, hipFuncAttributeMaxDynamicSharedMemorySize, LDS_BYTES) != hipSuccess) { fprintf(stderr, "kernel_launch: hipFuncSetAttribute failed\n"); grid = -1; return; }
        if (hipOccupancyMaxActiveBlocksPerMultiprocessor(&per_cu, (const void*)fwd_megakernel, NWAVES * 64, LDS_BYTES) != hipSuccess || per_cu < 1) { fprintf(stderr, "kernel_launch: occupancy query says %d\n", per_cu); per_cu = 1; }
        (void)hipGetLastError();
        grid = cus;
    }
    if (grid < 0) return;
    (void)hipMemsetAsync((char*)d_ws + WS_CTL, 0, CTL_ZERO_BYTES, stream);
    Args a{};
    for (int i = 0; i < 26; ++i) a.in[i] = (const float*)d_in[i];
    a.out = (float*)d_out; a.ws = (unsigned char*)d_ws;
    void* kargs[] = {&a};
    hipError_t e = hipLaunchCooperativeKernel((const void*)fwd_megakernel, dim3(grid), dim3(NWAVES * 64), kargs, LDS_BYTES, stream);
    if (e != hipSuccess) fprintf(stderr, "kernel_launch: cooperative launch failed: %s (grid %d)\n", hipGetErrorString(e), grid);
}
```
